# Optimizing an MI355X kernel written in HIP

```python
import math
import jax
import jax.numpy as jnp
from jax import lax
import numpy as np

D_MODEL = 1024
BATCH = 8
SEQ = 2048
DEPTH = 2

GRID_W = 64
CTX_LEN = 256
N_ATTN_LAYERS = (DEPTH + 1) // 2
N_REC_LAYERS = DEPTH // 2
EPS = 1e-6
Q_BLOCK = 128
ROPE_BASE = 10000.0

DA_HEADS = 4
DA_QK = 64
DA_V = 2 * DA_QK
DA_SCALE = DA_QK ** -0.5

MLA_HEADS = 8
MLA_NOPE = 64
MLA_ROPE = 32
MLA_V = 64
MLA_Q_RANK = 384
MLA_KV_RANK = 256
MLA_SCALE = (MLA_NOPE + MLA_ROPE) ** -0.5

ATT_SPLITS = (DA_HEADS * 2 * DA_QK, DA_HEADS * 2 * DA_QK, DA_HEADS * DA_V,
              MLA_Q_RANK, MLA_KV_RANK, MLA_ROPE)
ATT_IN = 3 * DA_HEADS * 2 * DA_QK + MLA_Q_RANK + MLA_KV_RANK + MLA_ROPE
ATT_OUT = DA_HEADS * DA_V + MLA_HEADS * MLA_V

GLA_HEADS = 4
GLA_DK = 64
GLA_DV = 128
GLA_GATE_RANK = 16
GLA_GATE_NORM = 16.0

HG_HEADS = 4
HG_DF = 128
HG_DV = 128

CHUNK = 64
REC_SPLITS = (GLA_HEADS * GLA_DK, GLA_HEADS * GLA_DK, GLA_HEADS * GLA_DV, GLA_HEADS * GLA_DV,
              2 * GLA_GATE_RANK, HG_HEADS * HG_DF, 2 * HG_HEADS * HG_DF, HG_HEADS * HG_DV, HG_HEADS * HG_DV)
REC_IN = (2 * GLA_HEADS * GLA_DK + 2 * GLA_HEADS * GLA_DV + 2 * GLA_GATE_RANK
          + 3 * HG_HEADS * HG_DF + 2 * HG_HEADS * HG_DV)
REC_OUT = GLA_HEADS * GLA_DV + HG_HEADS * HG_DV

N_EXPERTS = 16
EXPERT_FF = 2816
EC_CAPACITY_FACTOR = 2

kernel_name = 'hybrid_diffusion_diffattn_mla_gla_hgrn2_ecmoe'


def _split(t, sizes):
    return jnp.split(t, np.cumsum(sizes)[:-1].tolist(), axis=-1)


def rms_norm(x, gain):
    xf = x.astype(jnp.float32)
    y = xf * lax.rsqrt(jnp.mean(xf * xf, axis=-1, keepdims=True) + EPS)
    return (y * gain.astype(jnp.float32)).astype(x.dtype)


def modulate(x, gain, shift, scale):
    return rms_norm(x, gain) * (1 + scale) + shift


def axial_rope(rows, rot_dim):
    row = jnp.repeat(jnp.arange(rows, dtype=jnp.float32), GRID_W)
    col = jnp.tile(jnp.arange(GRID_W, dtype=jnp.float32), rows)
    n_freq = rot_dim // 4
    inv = ROPE_BASE ** (-jnp.arange(n_freq, dtype=jnp.float32) / n_freq)
    ang = jnp.concatenate([row[:, None] * inv, col[:, None] * inv], axis=-1)
    return jnp.cos(ang), jnp.sin(ang)


def apply_rope(x, cos, sin):
    shape = (1, x.shape[1]) + (1,) * (x.ndim - 3) + (cos.shape[-1],)
    cs = cos.reshape(shape).astype(x.dtype)
    sn = sin.reshape(shape).astype(x.dtype)
    x1, x2 = jnp.split(x, 2, axis=-1)
    return jnp.concatenate([x1 * cs - x2 * sn, x2 * cs + x1 * sn], axis=-1)


def over_query_blocks(fn, *qs):
    bsz, n = qs[0].shape[:2]
    nb = n // Q_BLOCK
    blocks = tuple(jnp.moveaxis(q.reshape((bsz, nb, Q_BLOCK) + q.shape[2:]), 1, 0) for q in qs)
    out = lax.map(lambda blk: fn(*blk), blocks)
    return jnp.moveaxis(out, 0, 1).reshape(bsz, n, out.shape[-1])


def attn_project(h, w_in, q_norm_g, q_up, kv_norm_g, kv_up, rope):
    bsz, n, _ = h.shape
    qa, ka, va, cq, ckv, kr = _split(h @ w_in, ATT_SPLITS)
    qa = qa.reshape(bsz, n, DA_HEADS, 2, DA_QK)
    ka = ka.reshape(bsz, n, DA_HEADS, 2, DA_QK)
    va = va.reshape(bsz, n, DA_HEADS, DA_V)
    qm = (rms_norm(cq, q_norm_g) @ q_up).reshape(bsz, n, MLA_HEADS, MLA_NOPE + MLA_ROPE)
    kvm = (rms_norm(ckv, kv_norm_g) @ kv_up).reshape(bsz, n, MLA_HEADS, MLA_NOPE + MLA_V)
    q_nope, q_rope = qm[..., :MLA_NOPE], qm[..., MLA_NOPE:]
    k_nope, vm = kvm[..., :MLA_NOPE], kvm[..., MLA_NOPE:]
    k_rope = kr[:, :, None, :]
    if rope is not None:
        cos_da, sin_da, cos_r, sin_r = rope
        qa = apply_rope(qa, cos_da, sin_da)
        ka = apply_rope(ka, cos_da, sin_da)
        q_rope = apply_rope(q_rope, cos_r, sin_r)
        k_rope = apply_rope(k_rope, cos_r, sin_r)
    qm = jnp.concatenate([q_nope, q_rope], axis=-1)
    km = jnp.concatenate([k_nope, jnp.broadcast_to(k_rope, (bsz, n, MLA_HEADS, MLA_ROPE))], axis=-1)
    queries = (qa[..., 0, :], qa[..., 1, :], qm)
    keys = (ka[..., 0, :], ka[..., 1, :], va, km, vm)
    return queries, keys


def attn_heads(q1, q2, qm, keys, lam, lam_init, subln_g):
    k1, k2, va, km, vm = keys
    bsz, nq = q1.shape[:2]
    s1 = jnp.einsum('bqhd,bkhd->bhqk', q1, k1).astype(jnp.float32) * DA_SCALE
    s2 = jnp.einsum('bqhd,bkhd->bhqk', q2, k2).astype(jnp.float32) * DA_SCALE
    p = jax.nn.softmax(s1, axis=-1) - lam * jax.nn.softmax(s2, axis=-1)
    oa = jnp.einsum('bhqk,bkhd->bqhd', p.astype(va.dtype), va)
    oa = rms_norm(oa, subln_g) * (1.0 - lam_init)
    sm = jnp.einsum('bqhd,bkhd->bhqk', qm, km).astype(jnp.float32) * MLA_SCALE
    om = jnp.einsum('bhqk,bkhd->bqhd', jax.nn.softmax(sm, axis=-1).astype(vm.dtype), vm)
    return jnp.concatenate([oa.reshape(bsz, nq, -1), om.reshape(bsz, nq, -1)], axis=-1)


def attn_mixer(hl, hc, rope, layer_idx, w_in, q_norm_g, q_up, kv_norm_g, kv_up,
               lam_q1, lam_k1, lam_q2, lam_k2, subln_g, w_out, need_ctx):
    lam_init = 0.8 - 0.6 * math.exp(-0.3 * layer_idx)
    f32 = jnp.float32
    lam = (jnp.exp(jnp.sum(lam_q1.astype(f32) * lam_k1.astype(f32)))
           - jnp.exp(jnp.sum(lam_q2.astype(f32) * lam_k2.astype(f32))) + lam_init)
    ql, kl = attn_project(hl, w_in, q_norm_g, q_up, kv_norm_g, kv_up, rope)
    qc, kc = attn_project(hc, w_in, q_norm_g, q_up, kv_norm_g, kv_up, None)
    k_all = tuple(jnp.concatenate([a, b], axis=1) for a, b in zip(kc, kl))
    out_l = over_query_blocks(
        lambda q1, q2, qm: attn_heads(q1, q2, qm, k_all, lam, lam_init, subln_g), *ql) @ w_out
    out_c = attn_heads(qc[0], qc[1], qc[2], kc, lam, lam_init, subln_g) @ w_out if need_ctx else None
    return out_l, out_c


def chunk_gla(q, k, v, log_a, s0, readout=True):
    bsz, t, nh, _ = k.shape
    dv = v.shape[-1]
    nc = t // CHUNK
    f32 = jnp.float32

    def chunks(a):
        return a.astype(f32).reshape(bsz, nc, CHUNK, nh, a.shape[-1])

    kc, vc = chunks(k), chunks(v)
    b = jnp.cumsum(chunks(log_a), axis=2)
    b_last = b[:, :, -1:]
    kv = jnp.einsum('bnlhk,bnlhv->nbhkv', kc * jnp.exp(b_last - b), vc)
    decay = jnp.moveaxis(jnp.exp(b_last[:, :, 0]), 1, 0)

    def step(s, inp):
        dec, upd = inp
        return dec[..., None] * s + upd, s

    s_final, s_start = lax.scan(step, s0, (decay, kv))
    if not readout:
        return None, s_final
    qc = chunks(q)
    o = jnp.einsum('bnlhk,nbhkv->bnlhv', qc * jnp.exp(b), s_start)
    b_ref = b[:, :, CHUNK // 2:CHUNK // 2 + 1]
    scores = jnp.einsum('bnihk,bnjhk->bnhij', qc * jnp.exp(b - b_ref), kc * jnp.exp(b_ref - b))
    scores = jnp.where(jnp.tril(jnp.ones((CHUNK, CHUNK), dtype=bool)), scores, 0.0)
    o = o + jnp.einsum('bnhij,bnjhv->bnihv', scores, vc)
    return o.reshape(bsz, t, nh, dv).astype(v.dtype), s_final


def bidir_scan(fc, fl, name, need_ctx):
    q_l, v_l = fl[name + '_q'], fl[name + '_v']
    bsz, _, nh, dk = q_l.shape
    s0 = jnp.zeros((bsz, nh, dk, v_l.shape[-1]), jnp.float32)
    outs_l, outs_c = [], []
    for d in range(2):
        rev = (lambda t: jnp.flip(t, axis=1)) if d == 1 else (lambda t: t)
        oc, s_ctx = chunk_gla(rev(fc[name + '_q']), rev(fc[name + '_k'][d]), rev(fc[name + '_v']),
                              rev(fc[name + '_la'][d]), s0, readout=need_ctx)
        ol, _ = chunk_gla(rev(q_l), rev(fl[name + '_k'][d]), rev(v_l), rev(fl[name + '_la'][d]), s_ctx)
        outs_l.append(rev(ol))
        if need_ctx:
            outs_c.append(rev(oc))
    o_l = outs_l[0] + outs_l[1]
    o_c = outs_c[0] + outs_c[1] if need_ctx else None
    return o_l, o_c


def rec_features(h, w_in, gk_up, gk_bias, lb):
    bsz, n, _ = h.shape

    def heads(t, nh):
        return t.reshape(bsz, n, nh, -1)

    gq, gk, gv, gg, gdown, hq, hf, hi, hg = _split(h @ w_in, REC_SPLITS)
    gla_la = [heads(jax.nn.log_sigmoid((gd @ gk_up[d] + gk_bias[d]).astype(jnp.float32)) / GLA_GATE_NORM,
                    GLA_HEADS) for d, gd in enumerate(jnp.split(gdown, 2, axis=-1))]
    gla_k = heads(gk, GLA_HEADS)
    hg_f = [lb[d] + (1.0 - lb[d]) * jax.nn.sigmoid(fd.astype(jnp.float32))
            for d, fd in enumerate(jnp.split(hf, 2, axis=-1))]
    return {
        'gla_q': heads(gq, GLA_HEADS) * GLA_DK ** -0.5,
        'gla_k': [gla_k, gla_k],
        'gla_v': heads(gv, GLA_HEADS),
        'gla_la': gla_la,
        'gla_gate': gg,
        'hg_q': heads(jax.nn.silu(hq), HG_HEADS),
        'hg_k': [heads(1.0 - f, HG_HEADS) for f in hg_f],
        'hg_v': heads(hi, HG_HEADS),
        'hg_la': [heads(jnp.log(f), HG_HEADS) for f in hg_f],
        'hg_gate': hg,
    }


def rec_mixer(hl, hc, w_in, gk_up, gk_bias, gla_norm_g, lb, hg_norm_g, w_out, need_ctx):
    fl = rec_features(hl, w_in, gk_up, gk_bias, lb)
    fc = rec_features(hc, w_in, gk_up, gk_bias, lb)
    gla_l, gla_c = bidir_scan(fc, fl, 'gla', need_ctx)
    hg_l, hg_c = bidir_scan(fc, fl, 'hg', need_ctx)

    def readout(o_gla, o_hg, f):
        bsz, n = o_gla.shape[:2]
        a = rms_norm(o_gla, gla_norm_g).reshape(bsz, n, -1) * jax.nn.silu(f['gla_gate'])
        b = rms_norm(o_hg, hg_norm_g).reshape(bsz, n, -1) * jax.nn.silu(f['hg_gate'])
        return jnp.concatenate([a, b], axis=-1) @ w_out

    out_l = readout(gla_l, hg_l, fl)
    out_c = readout(gla_c, hg_c, fc) if need_ctx else None
    return out_l, out_c


def expert_choice_ffn(h, w_router, w_gate, w_up, w_down):
    bsz, n, d = h.shape
    cap = EC_CAPACITY_FACTOR * n // N_EXPERTS
    aff = jax.nn.softmax((h @ w_router).astype(jnp.float32), axis=-1)
    gate, idx = lax.top_k(jnp.swapaxes(aff, 1, 2), cap)
    xe = jax.vmap(lambda hb, ib: hb[ib])(h, idx)
    hid = jax.nn.silu(jnp.einsum('becd,edf->becf', xe, w_gate)) * jnp.einsum('becd,edf->becf', xe, w_up)
    ye = jnp.einsum('becf,efd->becd', hid, w_down) * gate[..., None].astype(h.dtype)
    return jax.vmap(lambda yb, ib: jnp.zeros((n, d), yb.dtype).at[ib.reshape(-1)].add(yb.reshape(-1, d)))(ye, idx)


def setup_inputs(seed: int = 0) -> dict:
    key = jax.random.key(seed)
    ks = iter(jax.random.split(key, 64))

    def nrm(shape, scale):
        return jax.random.normal(next(ks), shape, jnp.float32) * scale

    def gain(shape):
        return 1.0 + nrm(shape, 0.02)

    D, NA, NR, E, F = D_MODEL, N_ATTN_LAYERS, N_REC_LAYERS, N_EXPERTS, EXPERT_FF
    return {
        'x': nrm((BATCH, SEQ, D), 1.0),
        'c': nrm((BATCH, D), 1.0),
        'ctx': nrm((BATCH, CTX_LEN, D), 1.0),
        'c_ctx': nrm((D,), 1.0),
        'ada_w': nrm((DEPTH, D, 6 * D), 0.5 * D ** -0.5),
        'ada_b': nrm((DEPTH, 6 * D), 0.02),
        'norm1_g': gain((DEPTH, D)),
        'norm2_g': gain((DEPTH, D)),
        'att_w_in': nrm((NA, D, ATT_IN), D ** -0.5),
        'mla_q_norm_g': gain((NA, MLA_Q_RANK)),
        'mla_q_up': nrm((NA, MLA_Q_RANK, MLA_HEADS * (MLA_NOPE + MLA_ROPE)), MLA_Q_RANK ** -0.5),
        'mla_kv_norm_g': gain((NA, MLA_KV_RANK)),
        'mla_kv_up': nrm((NA, MLA_KV_RANK, MLA_HEADS * (MLA_NOPE + MLA_V)), MLA_KV_RANK ** -0.5),
        'da_lam_q1': nrm((NA, DA_QK), 0.1),
        'da_lam_k1': nrm((NA, DA_QK), 0.1),
        'da_lam_q2': nrm((NA, DA_QK), 0.1),
        'da_lam_k2': nrm((NA, DA_QK), 0.1),
        'da_subln_g': gain((NA, DA_V)),
        'att_w_out': nrm((NA, ATT_OUT, D), ATT_OUT ** -0.5),
        'rec_w_in': nrm((NR, D, REC_IN), D ** -0.5),
        'gla_gk_up': nrm((NR, 2, GLA_GATE_RANK, GLA_HEADS * GLA_DK), GLA_GATE_RANK ** -0.5),
        'gla_gk_bias': nrm((NR, 2, GLA_HEADS * GLA_DK), 0.02),
        'gla_norm_g': gain((NR, GLA_DV)),
        'hg_lb_logits': nrm((DEPTH, 2, HG_HEADS * HG_DF), 0.1),
        'hg_norm_g': gain((NR, HG_DV)),
        'rec_w_out': nrm((NR, REC_OUT, D), REC_OUT ** -0.5),
        'moe_router': nrm((DEPTH, D, E), D ** -0.5),
        'moe_w_gate': nrm((DEPTH, E, D, F), D ** -0.5),
        'moe_w_up': nrm((DEPTH, E, D, F), D ** -0.5),
        'moe_w_down': nrm((DEPTH, E, F, D), F ** -0.5),
        'final_norm_g': gain((D,)),
    }


def reference(x, c, ctx, c_ctx, ada_w, ada_b, norm1_g, norm2_g, att_w_in, mla_q_norm_g, mla_q_up,
              mla_kv_norm_g, mla_kv_up, da_lam_q1, da_lam_k1, da_lam_q2, da_lam_k2, da_subln_g, att_w_out,
              rec_w_in, gla_gk_up, gla_gk_bias, gla_norm_g, hg_lb_logits, hg_norm_g, rec_w_out,
              moe_router, moe_w_gate, moe_w_up, moe_w_down, final_norm_g):
    rows = x.shape[1] // GRID_W
    cos_da, sin_da = axial_rope(rows, DA_QK)
    cos_r, sin_r = axial_rope(rows, MLA_ROPE)
    rope = (cos_da, sin_da, cos_r, sin_r)
    lb = jax.nn.softmax(hg_lb_logits.astype(jnp.float32), axis=0)
    lb = jnp.cumsum(lb, axis=0) - lb[0]
    sc_l = jax.nn.silu(c)
    sc_c = jax.nn.silu(c_ctx)
    xl, xc = x, ctx
    for i in range(DEPTH):
        last = i == DEPTH - 1
        j = i // 2
        mod_l = jnp.split((sc_l @ ada_w[i] + ada_b[i])[:, None, :], 6, axis=-1)
        mod_c = jnp.split(sc_c @ ada_w[i] + ada_b[i], 6, axis=-1)
        hl = modulate(xl, norm1_g[i], mod_l[0], mod_l[1])
        hc = modulate(xc, norm1_g[i], mod_c[0], mod_c[1])
        if i % 2 == 0:
            ml, mc = attn_mixer(hl, hc, rope, i, att_w_in[j], mla_q_norm_g[j], mla_q_up[j], mla_kv_norm_g[j],
                                mla_kv_up[j], da_lam_q1[j], da_lam_k1[j], da_lam_q2[j], da_lam_k2[j],
                                da_subln_g[j], att_w_out[j], not last)
        else:
            ml, mc = rec_mixer(hl, hc, rec_w_in[j], gla_gk_up[j], gla_gk_bias[j], gla_norm_g[j], lb[i],
                               hg_norm_g[j], rec_w_out[j], not last)
        xl = xl + mod_l[2] * ml
        hl = modulate(xl, norm2_g[i], mod_l[3], mod_l[4])
        xl = xl + mod_l[5] * expert_choice_ffn(hl, moe_router[i], moe_w_gate[i], moe_w_up[i], moe_w_down[i])
        if not last:
            xc = xc + mod_c[2] * mc
            hc = modulate(xc, norm2_g[i], mod_c[3], mod_c[4])
            xc = xc + mod_c[5] * expert_choice_ffn(hc, moe_router[i], moe_w_gate[i], moe_w_up[i], moe_w_down[i])
    return rms_norm(xl, final_norm_g)
```

```cpp
#include <hip/hip_runtime.h>
#include <cstdio>
#include <cstdint>

#ifndef MK_ONE_LAUNCH
#define MK_ONE_LAUNCH 0
#endif

constexpr int NB = 8, SEQ = 2048, CTX = 256, TT = CTX + SEQ, D = 1024, MT = NB * TT;
constexpr int ATT_IN = 2208, REC_IN = 4128, NE = 16, FF = 2816, MEXP = 2304;
constexpr float EPS = 1e-6f;
constexpr int NT = 512, NWAVES = 8;

constexpr size_t MiB = 1u << 20;
constexpr size_t WS_CTL = 0, CTL_ZERO_BYTES = 1 * MiB;
constexpr size_t WS_MOD = 1 * MiB;
constexpr size_t WS_X = 2 * MiB;
constexpr size_t WS_H = 74 * MiB;
constexpr size_t WS_AFF = 146 * MiB;
constexpr size_t WS_SEL = 148 * MiB;
constexpr size_t WS_AROW = 150 * MiB;
constexpr size_t WS_GATE = 151 * MiB;
constexpr size_t WS_BIG = 152 * MiB;
constexpr size_t WS_QKV = WS_BIG;
constexpr size_t WS_CQN = WS_QKV + 156 * MiB;
constexpr size_t WS_CKVN = WS_CQN + 27 * MiB;
constexpr size_t WS_QM = WS_CKVN + 18 * MiB;
constexpr size_t WS_KVM = WS_QM + 54 * MiB;
constexpr size_t WS_KM = WS_KVM + 72 * MiB;
constexpr size_t WS_AO = WS_KM + 54 * MiB;
constexpr size_t WS_HID = WS_BIG;
constexpr size_t WS_Y = WS_HID + 396 * MiB;
constexpr size_t WS_REC = WS_BIG;
constexpr size_t WS_LA = WS_REC + 291 * MiB;
constexpr size_t WS_F = WS_LA + 36 * MiB;
constexpr size_t WS_OD = WS_F + 72 * MiB;
constexpr size_t WS_R = WS_OD + 144 * MiB;
constexpr size_t WS_END = WS_R + 72 * MiB;
static_assert(WS_AO + 72 * MiB <= WS_END && WS_Y + 144 * MiB <= WS_END, "ws map");

constexpr int CW_BAR = 4096;
constexpr int LDS_BYTES = 147456;
constexpr int MISC_OFF = 131072 + 320;

#define LAS __attribute__((address_space(3)))

#define XB_TMO      128
#define XB_XCNT(j)  (256  + 64 * (j))
#define XB_XSUB(j)  (1280 + 64 * (j))
#define XB_XGEN(j)  (2304 + 64 * (j))
#define XB_TOP      3328
#define XB_TOPGEN   3392
#define XCD_BAR_WORDS 3456
#define XB_SPIN_CAP (1u << 25)

__device__ __forceinline__ unsigned xb_ld(unsigned* p)              { return __hip_atomic_load(p, __ATOMIC_RELAXED, __HIP_MEMORY_SCOPE_AGENT); }
__device__ __forceinline__ unsigned xb_add(unsigned* p, unsigned v) { return __hip_atomic_fetch_add(p, v, __ATOMIC_RELAXED, __HIP_MEMORY_SCOPE_AGENT); }
__device__ __forceinline__ unsigned xb_xcc_id() { return (unsigned)__builtin_amdgcn_s_getreg((3 << 11) | 20) & 0xFu; }
#define XB_SPIN(cond, bar) do { unsigned _sp = 0; while (cond) { __builtin_amdgcn_s_sleep(1); \
    if ((++_sp & 255u) == 0u) { if (xb_ld(&(bar)[XB_TMO])) break; if (_sp > XB_SPIN_CAP) { atomicAdd(&(bar)[XB_TMO], 1u); break; } } } } while (0)

struct XcdBarrier { unsigned* bar; unsigned x; volatile LAS unsigned* st; };

__device__ __forceinline__ XcdBarrier xcd_barrier_post(unsigned* bar, volatile LAS unsigned* st) {
    XcdBarrier b; b.bar = bar; b.x = xb_xcc_id(); b.st = st;
    if (threadIdx.x == 0) (void)xb_add(&bar[XB_XCNT(b.x)], 1u);
    return b;
}
__device__ __forceinline__ void xcd_barrier_complete(unsigned* bar, unsigned x, unsigned& nloc, unsigned& nx) {
    const unsigned G = gridDim.x * gridDim.y * gridDim.z;
    unsigned sum, cnt, mine, sp = 0u;
    for (;;) {
        sum = 0u; cnt = 0u; mine = 0u;
#pragma unroll
        for (unsigned j = 0; j < 16; ++j) { const unsigned c = xb_ld(&bar[XB_XCNT(j)]); sum += c; cnt += (c > 0u) ? 1u : 0u; mine = (j == x) ? c : mine; }
        if (sum == G) break;
        __builtin_amdgcn_s_sleep(1);
        if ((++sp & 255u) == 0u) { if (xb_ld(&bar[XB_TMO])) break; if (sp > XB_SPIN_CAP) { atomicAdd(&bar[XB_TMO], 1u); break; } }
    }
    nloc = mine > 0u ? mine : 1u; nx = cnt > 0u ? cnt : 1u;
}
__device__ __forceinline__ void xcd_barrier(const XcdBarrier& b) {
    asm volatile("s_waitcnt vmcnt(0)" ::: "memory");
    __syncthreads();
    if (threadIdx.x == 0) {
        unsigned* bar = b.bar;
        __builtin_amdgcn_s_waitcnt(0);
        unsigned nloc = b.st[0], nx = b.st[1];
        if (nloc == 0u) { xcd_barrier_complete(bar, b.x, nloc, nx); b.st[0] = nloc; b.st[1] = nx; }
        const unsigned old = xb_add(&bar[XB_XSUB(b.x)], 1u);
        const unsigned gen = old / nloc;
        if (old + 1u == (gen + 1u) * nloc) {
            __builtin_amdgcn_fence(__ATOMIC_RELEASE, "agent");
            asm volatile("s_waitcnt vmcnt(0)" ::: "memory");
            const unsigned og = xb_add(&bar[XB_TOP], 1u);
            const unsigned tg = og / nx;
            if (og + 1u == (tg + 1u) * nx) xb_add(&bar[XB_TOPGEN], 1u);
            else XB_SPIN(xb_ld(&bar[XB_TOPGEN]) == tg, bar);
            __builtin_amdgcn_fence(__ATOMIC_ACQUIRE, "agent");
            xb_add(&bar[XB_XGEN(b.x)], 1u);
            asm volatile("s_waitcnt vmcnt(0)" ::: "memory");
        } else {
            XB_SPIN(xb_ld(&bar[XB_XGEN(b.x)]) == gen, bar);
            __builtin_amdgcn_fence(__ATOMIC_ACQUIRE, "agent");
            asm volatile("s_waitcnt vmcnt(0)" ::: "memory");
        }
    }
    __syncthreads();
}

__device__ __forceinline__ float wave_sum(float v) {
#pragma unroll
    for (int o = 1; o < 64; o <<= 1) v += __shfl_xor(v, o);
    return v;
}
__device__ __forceinline__ float siluf(float x) { return x / (1.f + expf(-x)); }
__device__ __forceinline__ float sigmoidf(float x) { return 1.f / (1.f + expf(-x)); }
__device__ __forceinline__ float log_sigmoidf(float x) { return fminf(x, 0.f) - log1pf(expf(-fabsf(x))); }
__device__ __forceinline__ int mod_index(int r) { const int b = r / TT; return (r - b * TT) < CTX ? 8 : b; }

struct GemmF { const float* A; int lda; const int* arow; const float* Bm; int ldb; int N, K; };
template <class Epi>
__device__ __forceinline__ void gemm_tile_f32(float* lds, const GemmF& g, int tm, int tn, const Epi& epi) {
    const int tid = threadIdx.x;
    float* As = lds;
    float* Bs = lds + 16 * 132;
    const int ty = tid >> 4, tx = tid & 15;
    float acc[4][8];
#pragma unroll
    for (int i = 0; i < 4; ++i)
#pragma unroll
        for (int j = 0; j < 8; ++j) acc[i][j] = 0.f;
    const int arl = tid >> 2, akq = tid & 3;
    const int grow = tm * 128 + arl;
    const float* ap = g.A + (size_t)(g.arow ? g.arow[grow] : grow) * g.lda + akq * 4;
    const int bk = tid >> 5, bc = (tid & 31) * 4, gcol = tn * 128 + bc;
    const bool bvalid = gcol < g.N;
    const float* bp = g.Bm + (size_t)bk * g.ldb + gcol;
    for (int k0 = 0; k0 < g.K; k0 += 16) {
        const float4 av = *(const float4*)(ap + k0);
        float4 bv = make_float4(0.f, 0.f, 0.f, 0.f);
        if (bvalid) bv = *(const float4*)(bp + (size_t)k0 * g.ldb);
        __syncthreads();
        As[(akq * 4 + 0) * 132 + arl] = av.x; As[(akq * 4 + 1) * 132 + arl] = av.y; As[(akq * 4 + 2) * 132 + arl] = av.z; As[(akq * 4 + 3) * 132 + arl] = av.w;
        *(float4*)&Bs[bk * 128 + bc] = bv;
        __syncthreads();
#pragma unroll
        for (int k = 0; k < 16; ++k) {
            const float4 a = *(const float4*)&As[k * 132 + ty * 4];
            const float4 b0 = *(const float4*)&Bs[k * 128 + tx * 8], b1 = *(const float4*)&Bs[k * 128 + tx * 8 + 4];
            const float aa[4] = {a.x, a.y, a.z, a.w};
            const float bb[8] = {b0.x, b0.y, b0.z, b0.w, b1.x, b1.y, b1.z, b1.w};
#pragma unroll
            for (int i = 0; i < 4; ++i)
#pragma unroll
                for (int j = 0; j < 8; ++j) acc[i][j] = fmaf(aa[i], bb[j], acc[i][j]);
        }
    }
#pragma unroll
    for (int i = 0; i < 4; ++i)
#pragma unroll
        for (int j = 0; j < 8; ++j) { const int row = tm * 128 + ty * 4 + i, col = tn * 128 + tx * 8 + j; if (col < g.N) epi(row, col, acc[i][j]); }
    __syncthreads();
}
struct EpiStore { float* C; int ldc; __device__ __forceinline__ void operator()(int r, int c, float v) const { C[(size_t)r * ldc + c] = v; } };
struct EpiSilu  { float* C; int ldc; __device__ __forceinline__ void operator()(int r, int c, float v) const { C[(size_t)r * ldc + c] = siluf(v); } };
struct EpiMul   { float* C; int ldc; __device__ __forceinline__ void operator()(int r, int c, float v) const { C[(size_t)r * ldc + c] *= v; } };
struct EpiResid { float* X; const float* gate;   __device__ __forceinline__ void operator()(int r, int c, float v) const { X[(size_t)r * D + c] += gate[mod_index(r) * 6144 + c] * v; } };

template <int DQK, int DV, int NMAPS>
__device__ __forceinline__ void attn_unit_f32(float* lds, const float* Qb, int ldq, const float* Kb, int ldk, int mapstride, const float* Vb, int ldv,
                                              int qrow0, int krow0, int nk, float scale, float lam, const float* subg, float outscale, float* Ob) {
    constexpr int QP = DQK + 1, NC = DV / 8;
    float* Qs = lds; float* Ks = Qs + 64 * QP; float* Vs = Ks + 64 * QP; float* Ps = Vs + 64 * DV;
    const int tid = threadIdx.x, qi = tid >> 3, sub = tid & 7;
    float res[NC];
#pragma unroll
    for (int c = 0; c < NC; ++c) res[c] = 0.f;
#pragma unroll
    for (int mp = 0; mp < NMAPS; ++mp) {
        __syncthreads();
        for (int i = tid; i < 64 * DQK; i += NT) { const int r = i / DQK, d = i - r * DQK; Qs[r * QP + d] = Qb[(size_t)(qrow0 + r) * ldq + mp * mapstride + d] * scale; }
        float m = -INFINITY, l = 0.f, o[NC];
#pragma unroll
        for (int c = 0; c < NC; ++c) o[c] = 0.f;
        for (int kt = 0; kt < nk; kt += 64) {
            __syncthreads();
            for (int i = tid; i < 64 * DQK; i += NT) { const int r = i / DQK, d = i - r * DQK; Ks[r * QP + d] = Kb[(size_t)(krow0 + kt + r) * ldk + mp * mapstride + d]; }
            for (int i = tid; i < 64 * DV; i += NT) { const int r = i / DV, d = i - r * DV; Vs[r * DV + d] = Vb[(size_t)(krow0 + kt + r) * ldv + d]; }
            __syncthreads();
            float s[8];
#pragma unroll
            for (int jj = 0; jj < 8; ++jj) s[jj] = 0.f;
            for (int d = 0; d < DQK; ++d) { const float q = Qs[qi * QP + d];
#pragma unroll
                for (int jj = 0; jj < 8; ++jj) s[jj] = fmaf(q, Ks[(sub + 8 * jj) * QP + d], s[jj]); }
            float tmax = s[0];
#pragma unroll
            for (int jj = 1; jj < 8; ++jj) tmax = fmaxf(tmax, s[jj]);
            tmax = fmaxf(tmax, __shfl_xor(tmax, 1)); tmax = fmaxf(tmax, __shfl_xor(tmax, 2)); tmax = fmaxf(tmax, __shfl_xor(tmax, 4));
            const float mn = fmaxf(m, tmax), alpha = expf(m - mn);
            float ps = 0.f;
#pragma unroll
            for (int jj = 0; jj < 8; ++jj) { const float p = expf(s[jj] - mn); ps += p; Ps[qi * 65 + sub + 8 * jj] = p; }
            ps += __shfl_xor(ps, 1); ps += __shfl_xor(ps, 2); ps += __shfl_xor(ps, 4);
            l = l * alpha + ps; m = mn;
#pragma unroll
            for (int c = 0; c < NC; ++c) o[c] *= alpha;
            __syncthreads();
            for (int j = 0; j < 64; ++j) { const float p = Ps[qi * 65 + j];
#pragma unroll
                for (int c = 0; c < NC; ++c) o[c] = fmaf(p, Vs[j * DV + sub + 8 * c], o[c]); }
        }
        const float inv = 1.f / l;
#pragma unroll
        for (int c = 0; c < NC; ++c) res[c] += (mp == 0 ? 1.f : -lam) * o[c] * inv;
    }
    if (NMAPS == 2) {
        float ss = 0.f;
#pragma unroll
        for (int c = 0; c < NC; ++c) ss += res[c] * res[c];
        ss += __shfl_xor(ss, 1); ss += __shfl_xor(ss, 2); ss += __shfl_xor(ss, 4);
        const float rstd = 1.f / sqrtf(ss * (1.f / DV) + EPS);
#pragma unroll
        for (int c = 0; c < NC; ++c) res[c] = res[c] * rstd * subg[sub + 8 * c] * outscale;
    }
#pragma unroll
    for (int c = 0; c < NC; ++c) Ob[(size_t)(qrow0 + qi) * D + sub + 8 * c] = res[c];
}

template <int KIND>
__device__ __forceinline__ void scan_unit_f32(float* lds, int b, int h, int dir, const float* REC, const float* LA, const float* Fg, float* OD) {
    constexpr int DK = KIND ? 128 : 64, KQ = DK / 4;
    const int tid = threadIdx.x, kg = __builtin_amdgcn_readfirstlane(tid >> 7), v = tid & 127;
    float S[KQ];
#pragma unroll
    for (int i = 0; i < KQ; ++i) S[i] = 0.f;
    float* obuf = lds;
    for (int s = 0; s < TT; ++s) {
        const int tp = s < CTX ? (dir ? CTX - 1 - s : s) : CTX + (dir ? SEQ - 1 - (s - CTX) : (s - CTX));
        const size_t r = (size_t)b * TT + tp;
        const float* rec = REC + r * REC_IN;
        const float vv = rec[(KIND ? 3104 : 512) + h * 128 + v];
        float o = 0.f;
#pragma unroll
        for (int i = 0; i < KQ; ++i) {
            const int kk = kg * KQ + i;
            float a, k, q;
            if (KIND == 0) { a = expf(LA[r * 512 + dir * 256 + h * 64 + kk]); k = rec[256 + h * 64 + kk]; q = rec[h * 64 + kk] * 0.125f; }
            else { const float f = Fg[r * 1024 + dir * 512 + h * 128 + kk]; a = f; k = 1.f - f; q = siluf(rec[1568 + h * 128 + kk]); }
            S[i] = fmaf(a, S[i], k * vv); o = fmaf(q, S[i], o);
        }
        if (s >= CTX) {
            const int u = s - CTX;
            obuf[((u & 31) * 4 + kg) * 128 + v] = o;
            if ((u & 31) == 31) {
                __syncthreads();
                for (int i = tid; i < 32 * 128; i += NT) { const int uu = i >> 7, v2 = i & 127;
                    const float sum = (obuf[(uu * 4 + 0) * 128 + v2] + obuf[(uu * 4 + 1) * 128 + v2]) + (obuf[(uu * 4 + 2) * 128 + v2] + obuf[(uu * 4 + 3) * 128 + v2]);
                    const int t = u - 31 + uu, tp2 = CTX + (dir ? SEQ - 1 - t : t);
                    OD[((size_t)dir * MT + (size_t)b * TT + tp2) * D + KIND * 512 + h * 128 + v2] = sum; }
                __syncthreads();
            }
        }
    }
}

struct Args { const float* in[31]; float* out; unsigned char* ws; int ph_lo, ph_hi; };
enum { I_X = 0, I_C, I_CTX, I_CCTX, I_ADAW, I_ADAB, I_N1G, I_N2G, I_ATTWIN, I_QNG, I_QUP, I_KVNG, I_KVUP, I_LQ1, I_LK1, I_LQ2, I_LK2, I_SUBLN, I_ATTWOUT,
       I_RECWIN, I_GKUP, I_GKB, I_GLANG, I_LBL, I_HGNG, I_RECWOUT, I_ROUTER, I_WG, I_WU, I_WD, I_FNG };
constexpr int N_PHASES = 32;

__device__ __forceinline__ void phase_norm2_router(const float* X, float* H, const float* g, const float* MODL, const float* wr, float* AFF, int* SEL, int bid, int nb) {
    const int tid = threadIdx.x, lane = tid & 63, wave = tid >> 6;
    for (int r = bid * NWAVES + wave; r < MT; r += nb * NWAVES) {
        const float4* xr = (const float4*)(X + (size_t)r * D) + lane;
        float4 v[4]; float ss = 0.f;
#pragma unroll
        for (int j = 0; j < 4; ++j) { v[j] = xr[64 * j]; ss += v[j].x * v[j].x + v[j].y * v[j].y + v[j].z * v[j].z + v[j].w * v[j].w; }
        ss = wave_sum(ss);
        const float rstd = 1.f / sqrtf(ss * (1.f / D) + EPS);
        const int mi = mod_index(r);
        const float* sh = MODL + mi * 6144 + 3 * 1024; const float* sc = MODL + mi * 6144 + 4 * 1024;
        float lg[16];
#pragma unroll
        for (int e = 0; e < 16; ++e) lg[e] = 0.f;
#pragma unroll
        for (int j = 0; j < 4; ++j) {
            const int c = (lane + 64 * j) * 4;
            const float4 g4 = *(const float4*)(g + c), s4 = *(const float4*)(sh + c), c4 = *(const float4*)(sc + c);
            float4 o;
            o.x = v[j].x * rstd * g4.x * (1.f + c4.x) + s4.x; o.y = v[j].y * rstd * g4.y * (1.f + c4.y) + s4.y;
            o.z = v[j].z * rstd * g4.z * (1.f + c4.z) + s4.z; o.w = v[j].w * rstd * g4.w * (1.f + c4.w) + s4.w;
            *((float4*)(H + (size_t)r * D) + lane + 64 * j) = o;
            const float oo[4] = {o.x, o.y, o.z, o.w};
#pragma unroll
            for (int q = 0; q < 4; ++q) {
                const float4* w4 = (const float4*)(wr + (size_t)(c + q) * 16);
#pragma unroll
                for (int e4 = 0; e4 < 4; ++e4) { const float4 w = w4[e4]; lg[e4 * 4 + 0] = fmaf(oo[q], w.x, lg[e4 * 4 + 0]); lg[e4 * 4 + 1] = fmaf(oo[q], w.y, lg[e4 * 4 + 1]);
                    lg[e4 * 4 + 2] = fmaf(oo[q], w.z, lg[e4 * 4 + 2]); lg[e4 * 4 + 3] = fmaf(oo[q], w.w, lg[e4 * 4 + 3]); }
            }
        }
        float mx = -INFINITY;
#pragma unroll
        for (int e = 0; e < 16; ++e) { lg[e] = wave_sum(lg[e]); mx = fmaxf(mx, lg[e]); }
        float den = 0.f;
#pragma unroll
        for (int e = 0; e < 16; ++e) { lg[e] = expf(lg[e] - mx); den += lg[e]; }
        float mine = 0.f;
#pragma unroll
        for (int e = 0; e < 16; ++e) if (lane == e) mine = lg[e] / den;
        if (lane < 16) { AFF[(size_t)r * 16 + lane] = mine; SEL[(size_t)r * 16 + lane] = -1; }
    }
}

__device__ __forceinline__ void phase_topk(float* lds, const float* AFF, int* SEL, int* AROW, float* GATE, bool with_ctx, int bid, int nb) {
    const int tid = threadIdx.x;
    const int nunits = with_ctx ? 256 : 128;
    for (int u = bid; u < nunits; u += nb) {
        const int kind = u >> 7, b = (u >> 4) & 7, e = u & 15;
        const int n = kind ? CTX : SEQ, cap = kind ? 32 : 256, row0 = b * TT + (kind ? 0 : CTX);
        __syncthreads();
        for (int i = tid; i < n; i += NT) lds[i] = AFF[(size_t)(row0 + i) * 16 + e];
        __syncthreads();
        for (int i = tid; i < n; i += NT) {
            const float vi = lds[i]; int rank = 0;
            for (int j = 0; j < n; ++j) { const float vj = lds[j]; rank += (vj > vi || (vj == vi && j < i)) ? 1 : 0; }
            if (rank < cap) { const int m = kind ? 2048 + b * 32 + rank : b * 256 + rank;
                AROW[e * MEXP + m] = row0 + i; GATE[e * MEXP + m] = vi; SEL[(size_t)(row0 + i) * 16 + e] = m; }
        }
    }
}

__device__ __forceinline__ void phase_combine(float* X, const float* Y, const int* SEL, const float* GATE, const float* MODL, bool latent_only, const float* fng, float* out, int bid, int nb) {
    const int tid = threadIdx.x, lane = tid & 63, wave = tid >> 6;
    for (int r = bid * NWAVES + wave; r < MT; r += nb * NWAVES) {
        const int b = r / TT, tp = r - b * TT;
        if (latent_only && tp < CTX) continue;
        float4 acc[4];
#pragma unroll
        for (int j = 0; j < 4; ++j) acc[j] = make_float4(0.f, 0.f, 0.f, 0.f);
        for (int e = 0; e < 16; ++e) {
            const int m = SEL[(size_t)r * 16 + e];
            if (m >= 0) { const float gt = GATE[e * MEXP + m]; const float4* y = (const float4*)(Y + ((size_t)e * MEXP + m) * D) + lane;
#pragma unroll
                for (int j = 0; j < 4; ++j) { const float4 yv = y[64 * j]; acc[j].x += gt * yv.x; acc[j].y += gt * yv.y; acc[j].z += gt * yv.z; acc[j].w += gt * yv.w; } }
        }
        const float* gm = MODL + mod_index(r) * 6144 + 5 * 1024;
        float4* xr = (float4*)(X + (size_t)r * D) + lane;
        float4 xv[4]; float ss = 0.f;
#pragma unroll
        for (int j = 0; j < 4; ++j) { const float4 g4 = *((const float4*)gm + lane + 64 * j); float4 x = xr[64 * j];
            x.x += g4.x * acc[j].x; x.y += g4.y * acc[j].y; x.z += g4.z * acc[j].z; x.w += g4.w * acc[j].w; xr[64 * j] = x; xv[j] = x;
            ss += x.x * x.x + x.y * x.y + x.z * x.z + x.w * x.w; }
        if (out) {
            ss = wave_sum(ss); const float rstd = 1.f / sqrtf(ss * (1.f / D) + EPS);
            float4* orow = (float4*)(out + ((size_t)b * SEQ + (tp - CTX)) * D) + lane;
#pragma unroll
            for (int j = 0; j < 4; ++j) { const float4 g4 = *((const float4*)fng + lane + 64 * j); float4 o; o.x = xv[j].x * rstd * g4.x; o.y = xv[j].y * rstd * g4.y; o.z = xv[j].z * rstd * g4.z; o.w = xv[j].w * rstd * g4.w; orow[64 * j] = o; }
        }
    }
}

__device__ __forceinline__ void phase_norm1(const float* X, float* H, const float* g, const float* MODL, int bid, int nb) {
    const int tid = threadIdx.x, lane = tid & 63, wave = tid >> 6;
    for (int r = bid * NWAVES + wave; r < MT; r += nb * NWAVES) {
        const float4* xr = (const float4*)(X + (size_t)r * D) + lane;
        float4 v[4]; float ss = 0.f;
#pragma unroll
        for (int j = 0; j < 4; ++j) { v[j] = xr[64 * j]; ss += v[j].x * v[j].x + v[j].y * v[j].y + v[j].z * v[j].z + v[j].w * v[j].w; }
        ss = wave_sum(ss);
        const float rstd = 1.f / sqrtf(ss * (1.f / D) + EPS);
        const int mi = mod_index(r);
        const float* sh = MODL + mi * 6144; const float* sc = MODL + mi * 6144 + 1024;
#pragma unroll
        for (int j = 0; j < 4; ++j) {
            const int c = (lane + 64 * j) * 4;
            const float4 g4 = *(const float4*)(g + c), s4 = *(const float4*)(sh + c), c4 = *(const float4*)(sc + c);
            float4 o;
            o.x = v[j].x * rstd * g4.x * (1.f + c4.x) + s4.x; o.y = v[j].y * rstd * g4.y * (1.f + c4.y) + s4.y;
            o.z = v[j].z * rstd * g4.z * (1.f + c4.z) + s4.z; o.w = v[j].w * rstd * g4.w * (1.f + c4.w) + s4.w;
            *((float4*)(H + (size_t)r * D) + lane + 64 * j) = o;
        }
    }
}

template <int PASS>
__device__ __forceinline__ void phase_moe(float* lds, const float* H, const int* AROW, float* HID, float* Y, const float* wg, const float* wu, const float* wd, int mrows, int bid, int nb) {
    const int tmn = mrows / 128;
    if (PASS < 2) {
        const int nu = NE * tmn * 22;
        for (int u = bid; u < nu; u += nb) { const int e = u / (tmn * 22), rem = u - e * (tmn * 22), tm = rem / 22, tn = rem - tm * 22;
            GemmF g{H, D, AROW + e * MEXP, (PASS == 0 ? wg : wu) + (size_t)e * D * FF, FF, FF, D};
            float* hid = HID + (size_t)e * MEXP * FF;
            if (PASS == 0) gemm_tile_f32(lds, g, tm, tn, EpiSilu{hid, FF}); else gemm_tile_f32(lds, g, tm, tn, EpiMul{hid, FF}); }
    } else {
        const int nu = NE * tmn * 8;
        for (int u = bid; u < nu; u += nb) { const int e = u / (tmn * 8), rem = u - e * (tmn * 8), tm = rem / 8, tn = rem - tm * 8;
            GemmF g{HID + (size_t)e * MEXP * FF, FF, nullptr, wd + (size_t)e * FF * D, D, D, FF};
            gemm_tile_f32(lds, g, tm, tn, EpiStore{Y + (size_t)e * MEXP * D, D}); }
    }
}

__global__ void __launch_bounds__(NT, 2) fwd(Args args) {
    extern __shared__ __attribute__((aligned(16))) unsigned char lds_raw[];
    float* lds = (float*)lds_raw;
    const int tid = threadIdx.x, lane = tid & 63, wave = tid >> 6, bid = blockIdx.x, nb = gridDim.x;
    unsigned char* ws = args.ws;
    volatile LAS unsigned* MISC = (volatile LAS unsigned*)((LAS unsigned char*)lds_raw + MISC_OFF);
    if (tid < 32) MISC[tid] = 0u;
    __syncthreads();
    XcdBarrier bar; bar.bar = (unsigned*)(ws + WS_CTL) + CW_BAR; bar.x = 0; bar.st = nullptr;
#if MK_ONE_LAUNCH
    bar = xcd_barrier_post((unsigned*)(ws + WS_CTL) + CW_BAR, MISC + 8);
#endif
    const int lo = args.ph_lo, hi = args.ph_hi;
#ifdef ONLY_PHASE
#define IN(k) ((k) == ONLY_PHASE && lo <= (k) && (k) < hi)
#else
#define IN(k) (lo <= (k) && (k) < hi)
#endif
#if MK_ONE_LAUNCH
#define SEAM(k) do { if (IN(k) && IN((k) + 1)) xcd_barrier(bar); } while (0)
#else
#define SEAM(k) do { } while (0)
#endif
    float* MOD = (float*)(ws + WS_MOD); float* X = (float*)(ws + WS_X); float* H = (float*)(ws + WS_H);
    float* AFF = (float*)(ws + WS_AFF); int* SEL = (int*)(ws + WS_SEL); int* AROW = (int*)(ws + WS_AROW); float* GATE = (float*)(ws + WS_GATE);
    float* QKV = (float*)(ws + WS_QKV); float* CQN = (float*)(ws + WS_CQN); float* CKVN = (float*)(ws + WS_CKVN); float* QM = (float*)(ws + WS_QM);
    float* KVM = (float*)(ws + WS_KVM); float* KM = (float*)(ws + WS_KM); float* AO = (float*)(ws + WS_AO);
    float* HID = (float*)(ws + WS_HID); float* Y = (float*)(ws + WS_Y);
    float* REC = (float*)(ws + WS_REC); float* LA = (float*)(ws + WS_LA); float* Fg = (float*)(ws + WS_F); float* OD = (float*)(ws + WS_OD); float* R = (float*)(ws + WS_R);

    if (IN(0)) {
        const float* x = args.in[I_X]; const float* ctx = args.in[I_CTX];
        for (size_t i = (size_t)bid * NT + tid; i < (size_t)MT * 256; i += (size_t)nb * NT) {
            const int r = (int)(i >> 8), c4 = (int)(i & 255), b = r / TT, t = r - b * TT;
            const float4* src = (const float4*)(t < CTX ? ctx + ((size_t)b * CTX + t) * D : x + ((size_t)b * SEQ + (t - CTX)) * D);
            ((float4*)X)[i] = src[c4];
        }
        const float* c = args.in[I_C]; const float* cc = args.in[I_CCTX]; const float* adaw = args.in[I_ADAW]; const float* adab = args.in[I_ADAB];
        float* sc = lds; float* red = lds + 9 * 1024;
        for (int u = bid; u < 192; u += nb) {
            const int layer = u / 96, cb = u - layer * 96;
            __syncthreads();
            for (int i = tid; i < 9 * 1024; i += NT) { const int r = i >> 10, k = i & 1023; sc[i] = siluf(r < 8 ? c[r * 1024 + k] : cc[k]); }
            __syncthreads();
            const int kg = tid >> 6, col = cb * 64 + lane;
            float acc[9];
#pragma unroll
            for (int r = 0; r < 9; ++r) acc[r] = 0.f;
            for (int k = kg * 128; k < kg * 128 + 128; ++k) { const float w = adaw[((size_t)layer * 1024 + k) * 6144 + col];
#pragma unroll
                for (int r = 0; r < 9; ++r) acc[r] = fmaf(sc[r * 1024 + k], w, acc[r]); }
#pragma unroll
            for (int r = 0; r < 9; ++r) red[(kg * 9 + r) * 64 + lane] = acc[r];
            __syncthreads();
            for (int i = tid; i < 9 * 64; i += NT) { const int r = i >> 6, l = i & 63; float s = 0.f;
#pragma unroll
                for (int q = 0; q < 8; ++q) s += red[(q * 9 + r) * 64 + l];
                MOD[(layer * 9 + r) * 6144 + cb * 64 + l] = s + adab[layer * 6144 + cb * 64 + l]; }
        }
    }
    SEAM(0);
    if (IN(1)) phase_norm1(X, H, args.in[I_N1G], MOD, bid, nb);
    SEAM(1);
    if (IN(2)) {
        GemmF g{H, D, nullptr, args.in[I_ATTWIN], ATT_IN, ATT_IN, D};
        const int tn_n = (ATT_IN + 127) / 128, nu = (MT / 128) * tn_n;
        for (int u = bid; u < nu; u += nb) gemm_tile_f32(lds, g, u / tn_n, u % tn_n, EpiStore{QKV, ATT_IN});
    }
    SEAM(2);
    if (IN(3)) {
        const float* qg = args.in[I_QNG]; const float* kvg = args.in[I_KVNG];
        for (int r = bid * NWAVES + wave; r < MT; r += nb * NWAVES) {
            float* row = QKV + (size_t)r * ATT_IN;
            float q[6]; float ss = 0.f;
#pragma unroll
            for (int j = 0; j < 6; ++j) { q[j] = row[1536 + lane + 64 * j]; ss += q[j] * q[j]; }
            ss = wave_sum(ss); float rstd = 1.f / sqrtf(ss * (1.f / 384) + EPS);
#pragma unroll
            for (int j = 0; j < 6; ++j) CQN[(size_t)r * 384 + lane + 64 * j] = q[j] * rstd * qg[lane + 64 * j];
            float k[4]; ss = 0.f;
#pragma unroll
            for (int j = 0; j < 4; ++j) { k[j] = row[1920 + lane + 64 * j]; ss += k[j] * k[j]; }
            ss = wave_sum(ss); rstd = 1.f / sqrtf(ss * (1.f / 256) + EPS);
#pragma unroll
            for (int j = 0; j < 4; ++j) CKVN[(size_t)r * 256 + lane + 64 * j] = k[j] * rstd * kvg[lane + 64 * j];
            const int b = r / TT, tp = r - b * TT;
            if (tp >= CTX) {
                const int t = tp - CTX; const float prow = (float)(t >> 6), pcol = (float)(t & 63);
#pragma unroll
                for (int it = 0; it < 8; ++it) {
                    const int p = lane + 64 * it, vec = p >> 5, j = p & 31;
                    const float inv = powf(10000.f, -(float)(j & 15) * (1.f / 16.f));
                    const float ang = (j < 16 ? prow : pcol) * inv, cs = cosf(ang), sn = sinf(ang);
                    float* p1 = row + vec * 64 + j; const float x1 = p1[0], x2 = p1[32];
                    p1[0] = x1 * cs - x2 * sn; p1[32] = x2 * cs + x1 * sn;
                }
                if (lane < 16) { const int j = lane; const float inv = powf(10000.f, -(float)(j & 7) * (1.f / 8.f));
                    const float ang = (j < 8 ? prow : pcol) * inv, cs = cosf(ang), sn = sinf(ang);
                    float* p1 = row + 2176 + j; const float x1 = p1[0], x2 = p1[16];
                    p1[0] = x1 * cs - x2 * sn; p1[16] = x2 * cs + x1 * sn; }
            }
        }
    }
    SEAM(3);
    if (IN(4)) {
        GemmF g1{CQN, 384, nullptr, args.in[I_QUP], 768, 768, 384};
        GemmF g2{CKVN, 256, nullptr, args.in[I_KVUP], 1024, 1024, 256};
        const int n1 = (MT / 128) * 6, n2 = (MT / 128) * 8;
        for (int u = bid; u < n1 + n2; u += nb) {
            if (u < n1) gemm_tile_f32(lds, g1, u / 6, u % 6, EpiStore{QM, 768});
            else { const int v = u - n1; gemm_tile_f32(lds, g2, v / 8, v % 8, EpiStore{KVM, 1024}); }
        }
    }
    SEAM(4);
    if (IN(5)) {
        for (int r = bid * NWAVES + wave; r < MT; r += nb * NWAVES) {
            const int b = r / TT, tp = r - b * TT;
            float* qm = QM + (size_t)r * 768;
            if (tp >= CTX) {
                const int t = tp - CTX; const float prow = (float)(t >> 6), pcol = (float)(t & 63);
#pragma unroll
                for (int it = 0; it < 2; ++it) { const int p = lane + 64 * it, hh = p >> 4, j = p & 15;
                    const float inv = powf(10000.f, -(float)(j & 7) * (1.f / 8.f));
                    const float ang = (j < 8 ? prow : pcol) * inv, cs = cosf(ang), sn = sinf(ang);
                    float* p1 = qm + hh * 96 + 64 + j; const float x1 = p1[0], x2 = p1[16];
                    p1[0] = x1 * cs - x2 * sn; p1[16] = x2 * cs + x1 * sn; }
            }
            const float* kvm = KVM + (size_t)r * 1024; const float* kr = QKV + (size_t)r * ATT_IN + 2176; float* km = KM + (size_t)r * 768;
#pragma unroll
            for (int it = 0; it < 12; ++it) { const int i = lane + 64 * it, hh = i / 96, d = i - hh * 96; km[i] = d < 64 ? kvm[hh * 128 + d] : kr[d - 64]; }
        }
    }
    SEAM(5);
    if (IN(6)) {
        const float* lq1 = args.in[I_LQ1]; const float* lk1 = args.in[I_LK1]; const float* lq2 = args.in[I_LQ2]; const float* lk2 = args.in[I_LK2];
        float d1 = 0.f, d2 = 0.f;
        for (int i = 0; i < 64; ++i) { d1 = fmaf(lq1[i], lk1[i], d1); d2 = fmaf(lq2[i], lk2[i], d2); }
        const float lam_init = 0.2f, lam = expf(d1) - expf(d2) + lam_init;
        const int nu = NB * 36 * 12;
        for (int u = bid; u < nu; u += nb) {
            const int hh = u % 12, qt = (u / 12) % 36, b = u / (12 * 36);
            const int qrow0 = b * TT + qt * 64, krow0 = b * TT, nk = qt < 4 ? CTX : TT;
            if (hh < 4) attn_unit_f32<64, 128, 2>(lds, QKV + hh * 128, ATT_IN, QKV + 512 + hh * 128, ATT_IN, 64, QKV + 1024 + hh * 128, ATT_IN, qrow0, krow0, nk, 0.125f, lam, args.in[I_SUBLN], 1.f - lam_init, AO + hh * 128);
            else { const int h = hh - 4; attn_unit_f32<96, 64, 1>(lds, QM + h * 96, 768, KM + h * 96, 768, 0, KVM + h * 128 + 64, 1024, qrow0, krow0, nk, 0.10206207261596577f, 0.f, nullptr, 1.f, AO + 512 + h * 64); }
        }
    }
    SEAM(6);
    if (IN(7)) {
        GemmF g{AO, D, nullptr, args.in[I_ATTWOUT], D, D, D};
        const int nu = (MT / 128) * 8;
        for (int u = bid; u < nu; u += nb) gemm_tile_f32(lds, g, u / 8, u % 8, EpiResid{X, MOD + 2 * 1024});
    }
    SEAM(7);
    if (IN(8)) phase_norm2_router(X, H, args.in[I_N2G], MOD, args.in[I_ROUTER], AFF, SEL, bid, nb);
    SEAM(8);
    if (IN(9)) phase_topk(lds, AFF, SEL, AROW, GATE, true, bid, nb);
    SEAM(9);
    if (IN(10)) phase_moe<0>(lds, H, AROW, HID, Y, args.in[I_WG], args.in[I_WU], args.in[I_WD], MEXP, bid, nb);
    SEAM(10);
    if (IN(11)) phase_moe<1>(lds, H, AROW, HID, Y, args.in[I_WG], args.in[I_WU], args.in[I_WD], MEXP, bid, nb);
    SEAM(11);
    if (IN(12)) phase_moe<2>(lds, H, AROW, HID, Y, args.in[I_WG], args.in[I_WU], args.in[I_WD], MEXP, bid, nb);
    SEAM(12);
    if (IN(13)) phase_combine(X, Y, SEL, GATE, MOD, false, nullptr, nullptr, bid, nb);
    SEAM(13);
    const float* MOD1 = MOD + 9 * 6144;
    if (IN(14)) phase_norm1(X, H, args.in[I_N1G] + D, MOD1, bid, nb);
    SEAM(14);
    if (IN(15)) {
        GemmF g{H, D, nullptr, args.in[I_RECWIN], REC_IN, REC_IN, D};
        const int tn_n = (REC_IN + 127) / 128, nu = (MT / 128) * tn_n;
        for (int u = bid; u < nu; u += nb) gemm_tile_f32(lds, g, u / tn_n, u % tn_n, EpiStore{REC, REC_IN});
    }
    SEAM(15);
    if (IN(16)) {
        const float* gkup = args.in[I_GKUP]; const float* gkb = args.in[I_GKB]; const float* lbl = args.in[I_LBL];
        for (int r = bid * NWAVES + wave; r < MT; r += nb * NWAVES) {
            const float* rec = REC + (size_t)r * REC_IN;
#pragma unroll 1
            for (int it = 0; it < 8; ++it) { const int i = lane + 64 * it, d = i >> 8, n = i & 255;
                float s = gkb[d * 256 + n];
#pragma unroll
                for (int k = 0; k < 16; ++k) s = fmaf(rec[1536 + d * 16 + k], gkup[(d * 16 + k) * 256 + n], s);
                LA[(size_t)r * 512 + i] = log_sigmoidf(s) * (1.f / 16.f); }
#pragma unroll 2
            for (int it = 0; it < 16; ++it) { const int i = lane + 64 * it;
                const float l0 = lbl[i], l1 = lbl[1024 + i], mx = fmaxf(l0, l1), e0 = expf(l0 - mx), e1 = expf(l1 - mx), lb = e1 / (e0 + e1);
                Fg[(size_t)r * 1024 + i] = lb + (1.f - lb) * sigmoidf(rec[2080 + i]); }
        }
    }
    SEAM(16);
    if (IN(17)) {
        for (int u = bid; u < 128; u += nb) { const int dir = u & 1, h = (u >> 1) & 3, kind = (u >> 3) & 1, b = u >> 4;
            if (kind == 0) scan_unit_f32<0>(lds, b, h, dir, REC, LA, Fg, OD); else scan_unit_f32<1>(lds, b, h, dir, REC, LA, Fg, OD); }
    }
    SEAM(17);
    if (IN(18)) {
        const float* gng = args.in[I_GLANG]; const float* hng = args.in[I_HGNG];
        for (int r = bid * NWAVES + wave; r < MT; r += nb * NWAVES) {
            const int b = r / TT, tp = r - b * TT;
            const int c0 = lane * 16, kind = c0 >> 9;
            float o[16]; float ss = 0.f;
            if (tp >= CTX) {
#pragma unroll
                for (int j = 0; j < 16; ++j) { o[j] = OD[(size_t)r * D + c0 + j] + OD[((size_t)MT + r) * D + c0 + j]; ss += o[j] * o[j]; }
            } else {
#pragma unroll
                for (int j = 0; j < 16; ++j) o[j] = 0.f;
            }
            ss += __shfl_xor(ss, 1); ss += __shfl_xor(ss, 2); ss += __shfl_xor(ss, 4);
            const float rstd = 1.f / sqrtf(ss * (1.f / 128) + EPS);
            const float* gn = kind ? hng : gng; const float* gate = REC + (size_t)r * REC_IN + (kind ? 3616 : 1024) + (c0 - kind * 512);
#pragma unroll
            for (int j = 0; j < 16; ++j) R[(size_t)r * D + c0 + j] = (tp >= CTX) ? o[j] * rstd * gn[(c0 + j) & 127] * siluf(gate[j]) : 0.f;
        }
    }
    SEAM(18);
    if (IN(19)) {
        GemmF g{R, D, nullptr, args.in[I_RECWOUT], D, D, D};
        const int nu = (MT / 128) * 8;
        for (int u = bid; u < nu; u += nb) gemm_tile_f32(lds, g, u / 8, u % 8, EpiResid{X, MOD1 + 2 * 1024});
    }
    SEAM(19);
    if (IN(20)) phase_norm2_router(X, H, args.in[I_N2G] + D, MOD1, args.in[I_ROUTER] + D * NE, AFF, SEL, bid, nb);
    SEAM(20);
    if (IN(21)) phase_topk(lds, AFF, SEL, AROW, GATE, false, bid, nb);
    SEAM(21);
    const size_t WOFF = (size_t)NE * D * FF;
    if (IN(22)) phase_moe<0>(lds, H, AROW, HID, Y, args.in[I_WG] + WOFF, args.in[I_WU] + WOFF, args.in[I_WD] + WOFF, 2048, bid, nb);
    SEAM(22);
    if (IN(23)) phase_moe<1>(lds, H, AROW, HID, Y, args.in[I_WG] + WOFF, args.in[I_WU] + WOFF, args.in[I_WD] + WOFF, 2048, bid, nb);
    SEAM(23);
    if (IN(24)) phase_moe<2>(lds, H, AROW, HID, Y, args.in[I_WG] + WOFF, args.in[I_WU] + WOFF, args.in[I_WD] + WOFF, 2048, bid, nb);
    SEAM(24);
    if (IN(25)) phase_combine(X, Y, SEL, GATE, MOD1, true, args.in[I_FNG], args.out, bid, nb);
#undef IN
#undef SEAM
}

extern "C" void kernel_launch(void* const* d_in, const int* in_sizes, int n_in, void* d_out, int out_size, void* d_ws, size_t ws_size, hipStream_t stream) {
    static int grid = 0;
    if (grid == 0) {
        if (n_in != 31 || out_size != NB * SEQ * D || ws_size < WS_END) { fprintf(stderr, "kernel_launch: unexpected problem (n_in %d out %d ws %zu need %zu)\n", n_in, out_size, ws_size, (size_t)WS_END); grid = -1; return; }
        int dev = 0, cus = 0, per_cu = 0;
        if (hipGetDevice(&dev) != hipSuccess || hipDeviceGetAttribute(&cus, hipDeviceAttributeMultiprocessorCount, dev) != hipSuccess) { grid = -1; return; }
        if (hipFuncSetAttribute((const void*)fwd, hipFuncAttributeMaxDynamicSharedMemorySize, LDS_BYTES) != hipSuccess) { fprintf(stderr, "kernel_launch: hipFuncSetAttribute failed\n"); grid = -1; return; }
        if (hipOccupancyMaxActiveBlocksPerMultiprocessor(&per_cu, (const void*)fwd, NT, LDS_BYTES) != hipSuccess || per_cu < 1) { fprintf(stderr, "kernel_launch: occupancy query says %d\n", per_cu); }
        (void)hipGetLastError();
        grid = cus;
    }
    if (grid < 0) return;
    (void)hipMemsetAsync((char*)d_ws + WS_CTL, 0, CTL_ZERO_BYTES, stream);
    Args a{};
    for (int i = 0; i < 31; ++i) a.in[i] = (const float*)d_in[i];
    a.out = (float*)d_out; a.ws = (unsigned char*)d_ws;
#if MK_ONE_LAUNCH
    a.ph_lo = 0; a.ph_hi = N_PHASES;
    hipLaunchKernelGGL(fwd, dim3(grid), dim3(NT), LDS_BYTES, stream, a);
#else
    for (int p = 0; p < 26; ++p) { a.ph_lo = p; a.ph_hi = p + 1; hipLaunchKernelGGL(fwd, dim3(grid), dim3(NT), LDS_BYTES, stream, a); }
#endif
}
```

```cpp
#include <hip/hip_runtime.h>
#include <cstdio>
#include <cstdint>

#ifndef MK_ONE_LAUNCH
#define MK_ONE_LAUNCH 1
#endif
#ifndef PROBE_REP
#define PROBE_REP 0
#endif

constexpr int NB = 8, SEQ = 2048, CTX = 256, TT = CTX + SEQ, D = 1024, MT = NB * TT;
constexpr int ATT_IN = 2208, REC_IN = 4128, NE = 16, FF = 2816, MEXP = 2304;
constexpr float EPS = 1e-6f;
constexpr int NT = 512, NWAVES = 8;
constexpr float LOG2E = 1.4426950408889634f;
constexpr float QS_DA = 0.125f * LOG2E, QS_MLA = 0.10206207261596577f * LOG2E;

constexpr size_t MiB = 1u << 20;
constexpr size_t WS_CTL = 0, CTL_ZERO_BYTES = 1 * MiB;
constexpr size_t WS_MOD = 1 * MiB;
constexpr size_t WS_LB1 = WS_MOD + 512 * 1024;
constexpr size_t WS_RDA = 2 * MiB;
constexpr size_t WS_RR = 3 * MiB;
constexpr size_t WS_X = 4 * MiB;
constexpr size_t WS_H = 76 * MiB;
constexpr size_t WS_AFF = 112 * MiB;
constexpr size_t WS_SEL = 114 * MiB;
constexpr size_t WS_AROW = 116 * MiB;
constexpr size_t WS_GATE = 117 * MiB;
constexpr size_t WS_BIG = 118 * MiB;
constexpr size_t WS_QK = WS_BIG;
constexpr size_t WS_V1 = WS_BIG + 36 * MiB;
constexpr size_t WS_CQ = WS_BIG + 54 * MiB;
constexpr size_t WS_CKV = WS_BIG + 68 * MiB;
constexpr size_t WS_KR = WS_BIG + 77 * MiB;
constexpr size_t WS_QM = WS_BIG + 79 * MiB;
constexpr size_t WS_KVM = WS_BIG + 106 * MiB;
constexpr size_t WS_ODA = WS_BIG + 142 * MiB;
constexpr size_t WS_AO = WS_BIG + 214 * MiB;
constexpr size_t WS_H8 = WS_BIG;
constexpr size_t WS_HIDB = WS_BIG + 72 * MiB;
constexpr size_t WS_YF = WS_BIG + 270 * MiB;
constexpr size_t WS_Y2 = WS_BIG + 342 * MiB;
constexpr size_t WS_RB = WS_BIG;
constexpr size_t WS_LF = WS_BIG + 108 * MiB;
constexpr size_t WS_GD = WS_BIG + 180 * MiB;
constexpr size_t WS_KVT0 = WS_BIG + 183 * MiB;
constexpr size_t WS_KVT1 = WS_BIG + 255 * MiB;
constexpr size_t WS_SST0 = WS_BIG + 399 * MiB;
constexpr size_t WS_SST1 = WS_BIG + 431 * MiB;
constexpr size_t WS_DEC = WS_BIG + 495 * MiB;
constexpr size_t WS_R = WS_BIG + 498 * MiB;
constexpr size_t WS_WIN = WS_BIG + 534 * MiB;
constexpr size_t WS_WQ = WS_WIN + 5 * MiB;
constexpr size_t WS_WKV = WS_WQ + 1 * MiB;
constexpr size_t WS_WO = WS_WKV + 1 * MiB;
constexpr size_t WS_WRI = WS_WO + 2 * MiB;
constexpr size_t WS_WRO = WS_WRI + 9 * MiB;
constexpr size_t WS_WGU = WS_WRO + 2 * MiB;
constexpr size_t WS_WD = WS_WGU + 2 * 176 * MiB;
constexpr size_t WS_PSSQ = WS_WD + 2 * 88 * MiB;
constexpr size_t WS_END = WS_PSSQ + 2 * MiB;

constexpr int CW_BAR = 4096;
constexpr int LDS_BYTES = 147456;
constexpr int MISC_OFF = LDS_BYTES - 128;

#define LAS __attribute__((address_space(3)))

#define XB_TMO      128
#define XB_XCNT(j)  (256  + 64 * (j))
#define XB_XSUB(j)  (1280 + 64 * (j))
#define XB_XGEN(j)  (2304 + 64 * (j))
#define XB_TOP      3328
#define XB_TOPGEN   3392
#define XCD_BAR_WORDS 3456
#define XB_SPIN_CAP (1u << 25)

__device__ __forceinline__ unsigned xb_ld(unsigned* p)              { return __hip_atomic_load(p, __ATOMIC_RELAXED, __HIP_MEMORY_SCOPE_AGENT); }
__device__ __forceinline__ unsigned xb_add(unsigned* p, unsigned v) { return __hip_atomic_fetch_add(p, v, __ATOMIC_RELAXED, __HIP_MEMORY_SCOPE_AGENT); }
__device__ __forceinline__ unsigned xb_xcc_id() { return (unsigned)__builtin_amdgcn_s_getreg((3 << 11) | 20) & 0xFu; }
#define XB_SPIN(cond, bar) do { unsigned _sp = 0; while (cond) { __builtin_amdgcn_s_sleep(1); \
    if ((++_sp & 255u) == 0u) { if (xb_ld(&(bar)[XB_TMO])) break; if (_sp > XB_SPIN_CAP) { atomicAdd(&(bar)[XB_TMO], 1u); break; } } } } while (0)

struct XcdBarrier { unsigned* bar; unsigned x; volatile LAS unsigned* st; };

__device__ __forceinline__ XcdBarrier xcd_barrier_post(unsigned* bar, volatile LAS unsigned* st) {
    XcdBarrier b; b.bar = bar; b.x = xb_xcc_id(); b.st = st;
    if (threadIdx.x == 0) (void)xb_add(&bar[XB_XCNT(b.x)], 1u);
    return b;
}
__device__ __forceinline__ void xcd_barrier_complete(unsigned* bar, unsigned x, unsigned& nloc, unsigned& nx) {
    const unsigned G = gridDim.x * gridDim.y * gridDim.z;
    unsigned sum, cnt, mine, sp = 0u;
    for (;;) {
        sum = 0u; cnt = 0u; mine = 0u;
#pragma unroll
        for (unsigned j = 0; j < 16; ++j) { const unsigned c = xb_ld(&bar[XB_XCNT(j)]); sum += c; cnt += (c > 0u) ? 1u : 0u; mine = (j == x) ? c : mine; }
        if (sum == G) break;
        __builtin_amdgcn_s_sleep(1);
        if ((++sp & 255u) == 0u) { if (xb_ld(&bar[XB_TMO])) break; if (sp > XB_SPIN_CAP) { atomicAdd(&bar[XB_TMO], 1u); break; } }
    }
    nloc = mine > 0u ? mine : 1u; nx = cnt > 0u ? cnt : 1u;
}
__device__ __forceinline__ void xcd_barrier(const XcdBarrier& b) {
    asm volatile("s_waitcnt vmcnt(0)" ::: "memory");
    __syncthreads();
    if (threadIdx.x == 0) {
        unsigned* bar = b.bar;
        __builtin_amdgcn_s_waitcnt(0);
        unsigned nloc = b.st[0], nx = b.st[1];
        if (nloc == 0u) { xcd_barrier_complete(bar, b.x, nloc, nx); b.st[0] = nloc; b.st[1] = nx; }
        const unsigned old = xb_add(&bar[XB_XSUB(b.x)], 1u);
        const unsigned gen = old / nloc;
        if (old + 1u == (gen + 1u) * nloc) {
            __builtin_amdgcn_fence(__ATOMIC_RELEASE, "agent");
            asm volatile("s_waitcnt vmcnt(0)" ::: "memory");
            const unsigned og = xb_add(&bar[XB_TOP], 1u);
            const unsigned tg = og / nx;
            if (og + 1u == (tg + 1u) * nx) xb_add(&bar[XB_TOPGEN], 1u);
            else XB_SPIN(xb_ld(&bar[XB_TOPGEN]) == tg, bar);
            __builtin_amdgcn_fence(__ATOMIC_ACQUIRE, "agent");
            xb_add(&bar[XB_XGEN(b.x)], 1u);
            asm volatile("s_waitcnt vmcnt(0)" ::: "memory");
        } else {
            XB_SPIN(xb_ld(&bar[XB_XGEN(b.x)]) == gen, bar);
            __builtin_amdgcn_fence(__ATOMIC_ACQUIRE, "agent");
            asm volatile("s_waitcnt vmcnt(0)" ::: "memory");
        }
    }
    __syncthreads();
}

namespace pg8 {
#define PG8_LAS __attribute__((address_space(3)))
typedef unsigned short bf16_t;
typedef short bf16x8 __attribute__((ext_vector_type(8)));
typedef float f32x4 __attribute__((ext_vector_type(4)));
typedef unsigned u32x4 __attribute__((ext_vector_type(4)));
typedef int v8i32 __attribute__((ext_vector_type(8)));
constexpr int BM = 256, BK = 64, HALF = 128, HTB = HALF * BK * 2  , STAGE_BYTES = 8 * HTB, NXCD = 8, WGM = 8;

__host__ __device__ __forceinline__ int lds_byte(int r, int c) { const int st = (r >> 4) * 2 + (c >> 5), rr = r & 15, cc = c & 31, ob = rr * 64 + cc * 2; return st * 1024 + (ob ^ (((ob >> 9) & 1) << 5)); }
__host__ __device__ __forceinline__ void stage_rc(int b, int& R, int& C) { const int st = b / 1024, sb = b % 1024, swz = sb ^ (((sb >> 9) & 1) << 5); R = (st >> 1) * 16 + swz / 64; C = (st & 1) * 32 + (swz % 64) / 2; }
__host__ __device__ __forceinline__ int perm32(int rho) { const int n = rho >> 4, i = rho & 15; return 8 * (i >> 2) + 4 * n + (i & 3); }

struct Unit { int pm, pn, ks; };
struct Gemm { const bf16_t* A; const bf16_t* Bt; int M, N, K; };
struct StaticOrder {
    int nM, nN, nwg, G, c;
    __host__ __device__ void init(int M, int N, int G_, int c_) { nM = M / BM; nN = N / BM; nwg = nM * nN; G = G_; c = c_; }
    __host__ __device__ bool next(int i, Unit& u) const {
        const long L = (long)i * G + c; if (L >= nwg) return false;
        int wgid = (int)L; { const int q = nwg / NXCD, r = nwg % NXCD, xcd = wgid % NXCD, off = wgid / NXCD; wgid = (xcd < r ? xcd * (q + 1) : r * (q + 1) + (xcd - r) * q) + off; }
        const int nig = WGM * nN, gid = wgid / nig, fm = gid * WGM, gsz = (nM - fm) < WGM ? (nM - fm) : WGM;
        u.pm = fm + ((wgid % nig) % gsz); u.pn = (wgid % nig) / gsz; return true;
    }
    __device__ __forceinline__ void a_ready(const Unit&) const {}
    __device__ __forceinline__ void done(const Unit&) const {}
};
__device__ __forceinline__ unsigned cvt_pk_bf16(float lo, float hi) { unsigned r; asm volatile("v_cvt_pk_bf16_f32 %0, %1, %2" : "=v"(r) : "v"(lo), "v"(hi)); return r; }
typedef float f32x2 __attribute__((ext_vector_type(2)));

template <class Epi, class Sched, bool ALIGN_EPI = false, bool SP2 = false, bool GATHER = false, bool SPLITK = false, bool F8 = false>
__device__ __forceinline__ void gemm_phase(PG8_LAS unsigned char* lds, const Gemm g, const Sched& S, const Epi& E) {
    const int tid = threadIdx.x, wid = __builtin_amdgcn_readfirstlane(tid >> 6), lane = tid & 63, wr = wid >> 2, wc = wid & 3, fr = lane & 15, fq = lane >> 4;
    int K = g.K; asm volatile("" : "+s"(K));
    int nt = K / BK;
    unsigned voffA[2], voffB[2]; int gR[2]; unsigned gC2[2];
#pragma unroll
    for (int i = 0; i < 2; ++i) { int R, C; stage_rc(tid * 16 + i * 8192, R, C); const int Rb = Epi::PERM ? ((R & ~31) + perm32(R & 31)) : R;
        voffA[i] = (unsigned)(R * K + C) * 2u; voffB[i] = (unsigned)(Rb * K + C) * 2u; gR[i] = R; gC2[i] = (unsigned)C * 2u; }
    const size_t kstep = (size_t)(BK * 2);
    const size_t hstep = (size_t)HALF * K * 2;
    const size_t tstep = 2 * hstep;
    const unsigned ldsw = (unsigned)wid * 1024u;
    const int aoff = lds_byte(wr * 64 + fr, fq * 8), boff = lds_byte(wc * 32 + fr, fq * 8);
#define PG8_SA(b, h) (((b) * 2 + (h)) * HTB)
#define PG8_SB(b, h) ((4 + (b) * 2 + (h)) * HTB)
#define PG8_STAGE(bufoff, gbase, voff) do { _Pragma("unroll") for (int _i = 0; _i < 2; ++_i) \
        __builtin_amdgcn_global_load_lds((const unsigned*)((const char*)(gbase) + (voff)[_i]), (PG8_LAS unsigned*)(lds + (bufoff) + ldsw + _i * 8192), 16, 0, 0); } while (0)
#define PG8_LDA(dst, b, h) do { if constexpr (F8) { _Pragma("unroll") for (int m = 0; m < 4; ++m) { const bf16x8 lo_ = *(const PG8_LAS bf16x8*)(lds + PG8_SA(b, h) + aoff + m * 2048), hi_ = *(const PG8_LAS bf16x8*)(lds + PG8_SA(b, h) + aoff + m * 2048 + 1024); \
            dst##8[m] = __builtin_bit_cast(v8i32, __builtin_shufflevector(lo_, hi_, 0, 1, 2, 3, 4, 5, 6, 7, 8, 9, 10, 11, 12, 13, 14, 15)); } } \
        else { _Pragma("unroll") for (int m = 0; m < 4; ++m) _Pragma("unroll") for (int k = 0; k < 2; ++k) dst[m][k] = *(const PG8_LAS bf16x8*)(lds + PG8_SA(b, h) + aoff + m * 2048 + k * 1024); } } while (0)
#define PG8_LDB(dst, b, h) do { if constexpr (F8) { _Pragma("unroll") for (int n = 0; n < 2; ++n) { const bf16x8 lo_ = *(const PG8_LAS bf16x8*)(lds + PG8_SB(b, h) + boff + n * 2048), hi_ = *(const PG8_LAS bf16x8*)(lds + PG8_SB(b, h) + boff + n * 2048 + 1024); \
            dst##8[n] = __builtin_bit_cast(v8i32, __builtin_shufflevector(lo_, hi_, 0, 1, 2, 3, 4, 5, 6, 7, 8, 9, 10, 11, 12, 13, 14, 15)); } } \
        else { _Pragma("unroll") for (int n = 0; n < 2; ++n) _Pragma("unroll") for (int k = 0; k < 2; ++k) dst[n][k] = *(const PG8_LAS bf16x8*)(lds + PG8_SB(b, h) + boff + n * 2048 + k * 1024); } } while (0)
#define PG8_MMA(ai, bj, At, Bt) do { __builtin_amdgcn_s_setprio(1); _Pragma("unroll") for (int m = 0; m < 4; ++m) _Pragma("unroll") for (int n = 0; n < 2; ++n) { \
        if constexpr (F8) { acc[ai][bj][m][n] = __builtin_amdgcn_mfma_scale_f32_16x16x128_f8f6f4(Bt##8[n], At##8[m], acc[ai][bj][m][n], 0, 0, 0, 0x7f7f7f7f, 0, 0x7f7f7f7f); } \
        else { _Pragma("unroll") for (int k = 0; k < 2; ++k) acc[ai][bj][m][n] = __builtin_amdgcn_mfma_f32_16x16x32_bf16(Bt[n][k], At[m][k], acc[ai][bj][m][n], 0, 0, 0); } } \
        __builtin_amdgcn_s_setprio(0); \
        } while (0)
#define PG8_WAIT_V(n) asm volatile("s_waitcnt vmcnt(" #n ")" ::: "memory")
#define PG8_WAIT_L(n) asm volatile("s_waitcnt lgkmcnt(" #n ")" ::: "memory")
#define PG8_BAR __builtin_amdgcn_s_barrier()
#define PG8_SCHED __builtin_amdgcn_sched_barrier(0)
    Unit cur, nxt; int ui = 0;
    if (!S.next(0, cur)) return;
    PG8_LAS unsigned* gtab = (PG8_LAS unsigned*)(lds + 131584);
    unsigned gAc[2][2] = {{0u, 0u}, {0u, 0u}}, gAn[2][2] = {{0u, 0u}, {0u, 0u}};
    if constexpr (GATHER) {
        for (int i = 0; i < 13; ++i) { Unit u; if (!S.next(i, u)) break; if (tid < 256) gtab[i * 256 + tid] = (unsigned)S.arow(u)[tid] * (unsigned)(K * 2); }
        __syncthreads();
#pragma unroll
        for (int h = 0; h < 2; ++h)
#pragma unroll
            for (int i = 0; i < 2; ++i) gAc[h][i] = gtab[h * 128 + gR[i]] + gC2[i];
    }
    f32x4 acc[2][2][4][2];
#pragma unroll
    for (int a = 0; a < 2; ++a)
#pragma unroll
        for (int b = 0; b < 2; ++b)
#pragma unroll
            for (int m = 0; m < 4; ++m)
#pragma unroll
                for (int n = 0; n < 2; ++n) acc[a][b][m][n] = (f32x4){0.f, 0.f, 0.f, 0.f};
    bf16x8 At[4][2], B0[2][2], B1[2][2];
    v8i32 At8[4], B08[2], B18[2];
    const char* cA = GATHER ? (const char*)g.A : (const char*)g.A + (size_t)cur.pm * tstep; const char* cB = (const char*)g.Bt + (size_t)cur.pn * tstep;
    if constexpr (SPLITK) { cA += (size_t)S.kofs(cur) * 2; cB += (size_t)S.kofs(cur) * 2; nt = S.klen(cur) / BK; }
#define PG8_STA(bufoff, p, h, arr) do { if constexpr (GATHER) { PG8_STAGE(bufoff, p, arr[h]); } else { PG8_STAGE(bufoff, (p) + (h) * hstep, voffA); } } while (0)
    S.a_ready(cur);
    if constexpr (SP2) {
        PG8_STAGE(PG8_SB(0, 0), cB, voffB); PG8_STAGE(PG8_SB(0, 1), cB + hstep, voffB); PG8_STA(PG8_SA(0, 0), cA, 0, gAc); PG8_STA(PG8_SA(0, 1), cA, 1, gAc);
        if (wr == 1) PG8_BAR;
        PG8_WAIT_V(2); PG8_BAR;
        PG8_STAGE(PG8_SB(1, 0), cB + kstep, voffB); PG8_STA(PG8_SA(1, 0), cA + kstep, 0, gAc); PG8_STAGE(PG8_SB(1, 1), cB + hstep + kstep, voffB);
        PG8_WAIT_V(6); PG8_BAR;
    } else {
        PG8_STAGE(PG8_SB(0, 0), cB, voffB); PG8_STAGE(PG8_SA(0, 0), cA, voffA); PG8_STAGE(PG8_SB(0, 1), cB + hstep, voffB); PG8_STAGE(PG8_SA(0, 1), cA + hstep, voffA);
        if (wr == 1) PG8_BAR;
        PG8_WAIT_V(4); PG8_BAR;
        PG8_STAGE(PG8_SB(1, 0), cB + kstep, voffB); PG8_STAGE(PG8_SA(1, 0), cA + kstep, voffA); PG8_STAGE(PG8_SB(1, 1), cB + hstep + kstep, voffB);
        PG8_WAIT_V(6); PG8_BAR;
    }
    for (;;) {
        const bool has_next = S.next(ui + 1, nxt);
        const char* nA = GATHER ? cA : (has_next ? (const char*)g.A + (size_t)nxt.pm * tstep : cA); const char* nB = has_next ? (const char*)g.Bt + (size_t)nxt.pn * tstep : cB;
        const char* nA2 = nA; const char* nB2 = nB;
        if constexpr (SPLITK) { if (has_next) { nA2 += (size_t)S.kofs(nxt) * 2; nB2 += (size_t)S.kofs(nxt) * 2; } }
        if constexpr (GATHER) {
#pragma unroll
            for (int h = 0; h < 2; ++h)
#pragma unroll
                for (int i = 0; i < 2; ++i) gAn[h][i] = has_next ? gtab[(ui + 1) * 256 + h * 128 + gR[i]] + gC2[i] : gAc[h][i];
        }
        if constexpr (F8) {
#pragma unroll 1
            for (int tt = 0; tt < nt; ++tt) {
                const int pb = tt & 1, ob = pb ^ 1, i1 = tt + 1, i2 = tt + 2;
                const char* p1A = i1 < nt ? cA + (size_t)i1 * kstep : nA2 + (size_t)(i1 - nt) * kstep;
                const char* p2A = i2 < nt ? cA + (size_t)i2 * kstep : nA2 + (size_t)(i2 - nt) * kstep;
                const char* p2B = i2 < nt ? cB + (size_t)i2 * kstep : nB2 + (size_t)(i2 - nt) * kstep;
                unsigned g1[2][2], g2[2][2];
#pragma unroll
                for (int h = 0; h < 2; ++h)
#pragma unroll
                    for (int i = 0; i < 2; ++i) { g1[h][i] = i1 < nt ? gAc[h][i] : gAn[h][i]; g2[h][i] = i2 < nt ? gAc[h][i] : gAn[h][i]; }
                PG8_LDB(B0, pb, 0); PG8_LDB(B1, pb, 1); PG8_SCHED; PG8_LDA(At, pb, 0); PG8_STA(PG8_SA(ob, 1), p1A, 1, g1);
                PG8_WAIT_V(8); PG8_WAIT_L(0); PG8_BAR; PG8_MMA(0, 0, At, B0); PG8_MMA(0, 1, At, B1); PG8_BAR; PG8_SCHED;
                PG8_LDA(At, pb, 1); PG8_STAGE(PG8_SB(pb, 0), p2B, voffB); PG8_STAGE(PG8_SB(pb, 1), p2B + hstep, voffB); PG8_STA(PG8_SA(pb, 0), p2A, 0, g2);
                PG8_WAIT_V(8); PG8_WAIT_L(0); PG8_BAR; PG8_MMA(1, 0, At, B0); PG8_MMA(1, 1, At, B1); PG8_BAR; PG8_SCHED;
            }
        } else {
#pragma unroll 1
        for (int t = 0; t < nt; t += 2) {
            const bool last = (t == nt - 2);
            const char* a1 = cA + (size_t)(t + 1) * kstep;
            const char* a2 = last ? nA2 : cA + (size_t)(t + 2) * kstep; const char* b2 = last ? nB2 : cB + (size_t)(t + 2) * kstep;
            const char* a3 = a2 + kstep; const char* b3 = b2 + kstep;
            unsigned gS[2][2];
#pragma unroll
            for (int h = 0; h < 2; ++h)
#pragma unroll
                for (int i = 0; i < 2; ++i) gS[h][i] = last ? gAn[h][i] : gAc[h][i];
            if (last && has_next) S.a_ready(nxt);
            if constexpr (SP2) {
            PG8_LDB(B0, 0, 0); PG8_LDB(B1, 0, 1); PG8_SCHED; PG8_LDA(At, 0, 0); PG8_STA(PG8_SA(1, 1), a1, 1, gAc);
            PG8_WAIT_V(8); PG8_WAIT_L(0); PG8_BAR; PG8_MMA(0, 0, At, B0); PG8_MMA(0, 1, At, B1); PG8_BAR; PG8_SCHED;
            PG8_LDA(At, 0, 1); PG8_STAGE(PG8_SB(0, 0), b2, voffB); PG8_STAGE(PG8_SB(0, 1), b2 + hstep, voffB); PG8_STA(PG8_SA(0, 0), a2, 0, gS);
            PG8_WAIT_V(8); PG8_WAIT_L(0); PG8_BAR; PG8_MMA(1, 0, At, B0); PG8_MMA(1, 1, At, B1); PG8_BAR; PG8_SCHED;
            PG8_LDB(B0, 1, 0); PG8_LDB(B1, 1, 1); PG8_SCHED; PG8_LDA(At, 1, 0); PG8_STA(PG8_SA(0, 1), a2, 1, gS);
            PG8_WAIT_V(8); PG8_WAIT_L(0); PG8_BAR; PG8_MMA(0, 0, At, B0); PG8_MMA(0, 1, At, B1); PG8_BAR; PG8_SCHED;
            PG8_LDA(At, 1, 1); PG8_STAGE(PG8_SB(1, 0), b3, voffB); PG8_STAGE(PG8_SB(1, 1), b3 + hstep, voffB); PG8_STA(PG8_SA(1, 0), a3, 0, gS);
            PG8_WAIT_V(8); PG8_WAIT_L(0); PG8_BAR; PG8_MMA(1, 0, At, B0); PG8_MMA(1, 1, At, B1); PG8_BAR; PG8_SCHED;
            } else {
            PG8_LDB(B0, 0, 0); PG8_SCHED; PG8_LDA(At, 0, 0); PG8_STAGE(PG8_SA(1, 1), a1 + hstep, voffA);
            PG8_WAIT_L(8); PG8_BAR; PG8_WAIT_L(0); PG8_MMA(0, 0, At, B0); PG8_BAR; PG8_SCHED;
            PG8_LDB(B1, 0, 1); PG8_STAGE(PG8_SB(0, 0), b2, voffB);
            PG8_BAR; PG8_WAIT_L(0); PG8_MMA(0, 1, At, B1); PG8_BAR;
            PG8_LDA(At, 0, 1); PG8_STAGE(PG8_SA(0, 0), a2, voffA);
            PG8_BAR; PG8_WAIT_L(0); PG8_MMA(1, 0, At, B0); PG8_BAR; PG8_SCHED;
            PG8_STAGE(PG8_SB(0, 1), b2 + hstep, voffB);
            PG8_WAIT_V(6); PG8_BAR; PG8_MMA(1, 1, At, B1); PG8_BAR;
            PG8_LDB(B0, 1, 0); PG8_SCHED; PG8_LDA(At, 1, 0); PG8_STAGE(PG8_SA(0, 1), a2 + hstep, voffA);
            PG8_WAIT_L(8); PG8_BAR; PG8_WAIT_L(0); PG8_MMA(0, 0, At, B0); PG8_BAR; PG8_SCHED;
            PG8_LDB(B1, 1, 1); PG8_STAGE(PG8_SB(1, 0), b3, voffB);
            PG8_BAR; PG8_WAIT_L(0); PG8_MMA(0, 1, At, B1); PG8_BAR;
            PG8_LDA(At, 1, 1); PG8_STAGE(PG8_SA(1, 0), a3, voffA);
            PG8_BAR; PG8_WAIT_L(0); PG8_MMA(1, 0, At, B0); PG8_BAR; PG8_SCHED;
            PG8_STAGE(PG8_SB(1, 1), b3 + hstep, voffB);
            PG8_WAIT_V(6); PG8_BAR; PG8_MMA(1, 1, At, B1); PG8_BAR;
            }
        }
        }
        if constexpr (ALIGN_EPI) { if (wr == 0) PG8_BAR; }
        if constexpr (!Epi::AFTER_DRAIN) { E(acc, cur, wr, wc, fr, fq); S.done(cur); }
        if (!has_next) break;
#pragma unroll
        for (int a = 0; a < 2; ++a)
#pragma unroll
            for (int b = 0; b < 2; ++b)
#pragma unroll
                for (int m = 0; m < 4; ++m)
#pragma unroll
                    for (int n = 0; n < 2; ++n) acc[a][b][m][n] = (f32x4){0.f, 0.f, 0.f, 0.f};
        cur = nxt; cA = nA2; cB = nB2; ++ui;
        if constexpr (SPLITK) nt = S.klen(cur) / BK;
        if constexpr (GATHER) {
#pragma unroll
            for (int h = 0; h < 2; ++h)
#pragma unroll
                for (int i = 0; i < 2; ++i) gAc[h][i] = gAn[h][i]; }
        if constexpr (ALIGN_EPI) { if (wr == 1) PG8_BAR; }
    }
    PG8_WAIT_V(0);
    if constexpr (!ALIGN_EPI) { if (wr == 0) PG8_BAR; }
    PG8_BAR;
    if constexpr (Epi::AFTER_DRAIN) { E.fused(acc, cur, wr, wc, fr, fq, lds, wid, lane); S.done(cur); }
#undef PG8_SA
#undef PG8_SB
#undef PG8_STAGE
#undef PG8_STA
#undef PG8_LDA
#undef PG8_LDB
#undef PG8_MMA
#undef PG8_WAIT_V
#undef PG8_WAIT_L
#undef PG8_BAR
#undef PG8_SCHED
}
}

typedef unsigned short bf16_t;
typedef short v4i16_t __attribute__((ext_vector_type(4)));
typedef unsigned u32x4_t __attribute__((ext_vector_type(4)));
typedef unsigned u32x2_t __attribute__((ext_vector_type(2)));
typedef pg8::f32x4 f32x4;
__device__ __forceinline__ unsigned pk_bf16(float lo, float hi) { return pg8::cvt_pk_bf16(lo, hi); }
__device__ __forceinline__ float bf2f(bf16_t v) { return __builtin_bit_cast(float, (unsigned)v << 16); }
__device__ __forceinline__ unsigned pk4_fp8(float a, float b, float c, float d) { int w = 0; w = __builtin_amdgcn_cvt_pk_fp8_f32(a, b, w, false); w = __builtin_amdgcn_cvt_pk_fp8_f32(c, d, w, true); return (unsigned)w; }
constexpr float W8_SCALE = 64.f, W8_INV = 1.f / 64.f;
__device__ __forceinline__ float fast_silu(float x) { return x * __builtin_amdgcn_rcpf(1.f + __expf(-x)); }
__device__ __forceinline__ float wave_sum(float v) {
#pragma unroll
    for (int o = 1; o < 64; o <<= 1) v += __shfl_xor(v, o);
    return v;
}
__device__ __forceinline__ float siluf(float x) { return x / (1.f + expf(-x)); }
__device__ __forceinline__ float sigmoidf(float x) { return 1.f / (1.f + expf(-x)); }
__device__ __forceinline__ float log_sigmoidf(float x) { return fminf(x, 0.f) - log1pf(expf(-fabsf(x))); }
__device__ __forceinline__ int mod_index(int r) { const int b = r / TT; return (r - b * TT) < CTX ? 8 : b; }

template <class Map, bool F8OUT = false>
__device__ __forceinline__ void conv_item(const float* W, int ldw, int ncols, int K, int k0, int n0, bf16_t* WT, const Map& map, const float* kscale, LAS unsigned char* scr, int lane, float wscale = 1.f) {
    const int lr = lane >> 4, lc = (lane & 15) * 4;
    const bool cvalid = (n0 + lc) < ncols;
    float4 v[16];
#pragma unroll
    for (int i = 0; i < 16; ++i) { v[i] = make_float4(0.f, 0.f, 0.f, 0.f); if (cvalid) v[i] = *(const float4*)(W + (size_t)(k0 + 4 * i + lr) * ldw + n0 + lc); }
#pragma unroll
    for (int i = 0; i < 16; ++i) { const float sc = (kscale ? kscale[k0 + 4 * i + lr] : 1.f) * wscale;
        u32x2_t w; w.x = pk_bf16(v[i].x * sc, v[i].y * sc); w.y = pk_bf16(v[i].z * sc, v[i].w * sc);
        *(LAS u32x2_t*)(scr + (4 * i + lr) * 144 + (lane & 15) * 8) = w; }
    asm volatile("s_waitcnt lgkmcnt(0)" ::: "memory");
    const int g = lane >> 4, q = (lane >> 2) & 3, p = lane & 3, i16 = lane & 15;
#pragma unroll
    for (int s2 = 0; s2 < 8; ++s2) { const int nb = s2 >> 1, kc = (s2 & 1) * 4 + g;
        LAS unsigned char* a = scr + (kc * 8 + q) * 144 + (nb * 16 + 4 * p) * 2;
        const v4i16_t lo = __builtin_amdgcn_ds_read_tr16_b64_v4i16((LAS v4i16_t*)a), hi = __builtin_amdgcn_ds_read_tr16_b64_v4i16((LAS v4i16_t*)(a + 4 * 144));
        const int sc = n0 + nb * 16 + i16, drow = sc < ncols ? map(sc) : -1;
        u32x4_t o; const u32x2_t l2 = __builtin_bit_cast(u32x2_t, lo), h2 = __builtin_bit_cast(u32x2_t, hi); o.x = l2.x; o.y = l2.y; o.z = h2.x; o.w = h2.y;
        if constexpr (F8OUT) {
            u32x2_t o8;
            o8.x = pk4_fp8(__builtin_bit_cast(float, o.x << 16), __builtin_bit_cast(float, o.x & 0xffff0000u), __builtin_bit_cast(float, o.y << 16), __builtin_bit_cast(float, o.y & 0xffff0000u));
            o8.y = pk4_fp8(__builtin_bit_cast(float, o.z << 16), __builtin_bit_cast(float, o.z & 0xffff0000u), __builtin_bit_cast(float, o.w << 16), __builtin_bit_cast(float, o.w & 0xffff0000u));
            if (drow >= 0) *(u32x2_t*)((unsigned char*)WT + (size_t)drow * K + k0 + kc * 8) = o8;
        } else {
            if (drow >= 0) *(u32x4_t*)(WT + (size_t)drow * K + k0 + kc * 8) = o;
        } }
    asm volatile("s_waitcnt lgkmcnt(0)" ::: "memory");
}
template <class Map>
__device__ __forceinline__ void conv_item_tall8(const float* W, int ldw, int K, int k0, int n0, unsigned char* WT8, const Map& map, LAS unsigned char* scr, int lane, float wscale) {
    const int lr = lane >> 3, lc = (lane & 7) * 4;
    float4 v[16];
#pragma unroll
    for (int i = 0; i < 16; ++i) v[i] = *(const float4*)(W + (size_t)(k0 + 8 * i + lr) * ldw + n0 + lc);
#pragma unroll
    for (int i = 0; i < 16; ++i) { u32x2_t w; w.x = pk_bf16(v[i].x * wscale, v[i].y * wscale); w.y = pk_bf16(v[i].z * wscale, v[i].w * wscale);
        *(LAS u32x2_t*)(scr + (8 * i + lr) * 80 + (lane & 7) * 8) = w; }
    asm volatile("s_waitcnt lgkmcnt(0)" ::: "memory");
    const int g = lane >> 4, q = (lane >> 2) & 3, p = lane & 3, i16 = lane & 15;
#pragma unroll
    for (int s2 = 0; s2 < 4; ++s2) { const int nb = s2 >> 1, hk = s2 & 1;
        LAS unsigned char* a = scr + (64 * hk + 16 * g + q) * 80 + (nb * 16 + 4 * p) * 2;
        u32x4_t o8;
#pragma unroll
        for (int m = 0; m < 4; ++m) { const v4i16_t t4 = __builtin_amdgcn_ds_read_tr16_b64_v4i16((LAS v4i16_t*)(a + 4 * m * 80)); const u32x2_t t2 = __builtin_bit_cast(u32x2_t, t4);
            o8[m] = pk4_fp8(__builtin_bit_cast(float, t2.x << 16), __builtin_bit_cast(float, t2.x & 0xffff0000u), __builtin_bit_cast(float, t2.y << 16), __builtin_bit_cast(float, t2.y & 0xffff0000u)); }
        const int drow = map(n0 + nb * 16 + i16);
        *(u32x4_t*)(WT8 + (size_t)drow * K + k0 + 64 * hk + 16 * g) = o8; }
    asm volatile("s_waitcnt lgkmcnt(0)" ::: "memory");
}
constexpr int N_L1ITEMS = 2 * 16 * 3 * 704;
struct ConvItem { const float* W; unsigned char* WT8; int ldw, K, which, k0, n0; };
struct ConvCtx { const float* wg; const float* wu; const float* wd; unsigned char* WGU8; unsigned char* WDT8; int n, stride, offset; };
constexpr int N_TAIL2 = 120 * 8 * 4, N_TAIL10 = 160 * 8 * 2, N_TAIL14 = 56 * 8 * 4, N_TAILITEMS = N_TAIL2 + N_TAIL10 + N_TAIL14, N_ATTITEMS = N_L1ITEMS - N_TAILITEMS;
__device__ __forceinline__ int conv_att_limit(const ConvCtx& c) { return c.stride == 2048 ? N_ATTITEMS : N_L1ITEMS; }
__device__ __forceinline__ int conv_item_index(const ConvCtx& c, int n) {
    if (c.stride != 2048) return n * c.stride + c.offset;
    if (n < 21) return n * 2048 + c.offset;
    if (n < 26) return c.offset >= 256 ? 43008 + (n - 21) * 1792 + (c.offset - 256) : (1 << 30);
    return c.offset >= 768 ? 51968 + (n - 26) * 1280 + (c.offset - 768) : (1 << 30);
}
__device__ __forceinline__ ConvItem conv_decode_l1(const ConvCtx& c, int item) {
    const int le = item / 2112, r2 = item % 2112, which = r2 / 704, q = r2 - which * 704;
    ConvItem it; it.which = which;
    if (which < 2) { const int kb = q / 44, nbk = q - kb * 44; it.W = (which ? c.wu : c.wg) + (size_t)le * D * FF; it.ldw = FF; it.K = D; it.WT8 = c.WGU8 + (size_t)le * 5632 * D; it.k0 = kb * 64; it.n0 = nbk * 64; }
    else { const int kb = q / 16, nbk = q - kb * 16; it.W = c.wd + (size_t)le * FF * D; it.ldw = D; it.K = FF; it.WT8 = c.WDT8 + (size_t)le * D * FF; it.k0 = kb * 64; it.n0 = nbk * 64; }
    return it;
}
__device__ __forceinline__ void conv_q_issue(const ConvItem& it, int q, float4 (&cv)[8], int lane) {
    const float* src = it.W + (size_t)(it.k0 + 32 * q + (lane >> 4)) * it.ldw + it.n0 + (lane & 15) * 4;
#pragma unroll
    for (int i = 0; i < 8; ++i) { const f32x4 t = __builtin_nontemporal_load((const f32x4*)(src + (size_t)(4 * i) * it.ldw)); cv[i] = make_float4(t[0], t[1], t[2], t[3]); }
}
__device__ __forceinline__ void conv_q_stash(int q, const float4 (&cv)[8], LAS unsigned char* scr, int lane) {
#pragma unroll
    for (int i = 0; i < 8; ++i) { u32x2_t w; w.x = pk_bf16(cv[i].x * W8_SCALE, cv[i].y * W8_SCALE); w.y = pk_bf16(cv[i].z * W8_SCALE, cv[i].w * W8_SCALE);
        *(LAS u32x2_t*)(scr + (32 * q + 4 * i + (lane >> 4)) * 144 + (lane & 15) * 8) = w; }
}
__device__ __forceinline__ void conv_finish(const ConvItem& it, LAS unsigned char* scr, int lane) {
    asm volatile("s_waitcnt lgkmcnt(0)" ::: "memory");
    const int g = lane >> 4, q = (lane >> 2) & 3, p = lane & 3, i16 = lane & 15;
#pragma unroll
    for (int nb = 0; nb < 4; ++nb) {
        LAS unsigned char* a = scr + (16 * g + q) * 144 + (nb * 16 + 4 * p) * 2;
        u32x4_t o8;
#pragma unroll
        for (int m = 0; m < 4; ++m) { const v4i16_t t4 = __builtin_amdgcn_ds_read_tr16_b64_v4i16((LAS v4i16_t*)(a + 4 * m * 144)); const u32x2_t t2 = __builtin_bit_cast(u32x2_t, t4);
            o8[m] = pk4_fp8(__builtin_bit_cast(float, t2.x << 16), __builtin_bit_cast(float, t2.x & 0xffff0000u), __builtin_bit_cast(float, t2.y << 16), __builtin_bit_cast(float, t2.y & 0xffff0000u)); }
        const int n = it.n0 + nb * 16 + i16, drow = it.which < 2 ? (n >> 7) * 256 + it.which * 128 + (n & 127) : n;
        __builtin_nontemporal_store(o8, (u32x4_t*)(it.WT8 + (size_t)drow * it.K + it.k0 + 16 * g)); }
    asm volatile("s_waitcnt lgkmcnt(0)" ::: "memory");
}
__device__ __forceinline__ void conv_tail(const ConvCtx& c, LAS unsigned char* ldsl, int base, int per_wave, int widx, int nw, int limit) {
    const int lane = threadIdx.x & 63; LAS unsigned char* scr = ldsl + __builtin_amdgcn_readfirstlane(threadIdx.x >> 6) * 10240;
#pragma unroll 1
    for (int j = 0; j < per_wave; ++j) { const int item = base + j * nw + widx; if (item >= limit) break;
        const ConvItem it = conv_decode_l1(c, item); float4 cv0[8], cv1[8];
        conv_q_issue(it, 0, cv0, lane); conv_q_issue(it, 1, cv1, lane);
        conv_q_stash(0, cv0, scr, lane); conv_q_stash(1, cv1, scr, lane);
        conv_finish(it, scr, lane); }
}
__device__ __forceinline__ int ilv32(int i) { return i < 32 ? 2 * i : 2 * (i - 32) + 1; }
__device__ __forceinline__ int ilv16(int j) { return j < 16 ? 2 * j : 2 * (j - 16) + 1; }
struct MapIdent { __device__ __forceinline__ int operator()(int c) const { return c; } };
struct MapGateUp { int half; __device__ __forceinline__ int operator()(int f) const { return (f >> 7) * 256 + half * 128 + (f & 127); } };
struct MapAttIn { __device__ __forceinline__ int operator()(int c) const { if (c < 1024) return (c & ~63) + ilv32(c & 63); if (c < 2176) return c; return 2176 + ilv16(c - 2176); } };
struct MapQUp { __device__ __forceinline__ int operator()(int c) const { const int h = c / 96, d = c - h * 96; return d < 64 ? h * 64 + d : 512 + h * 32 + ilv16(d - 64); } };
struct MapKVUp { __device__ __forceinline__ int operator()(int c) const { const int h = c >> 7, d = c & 127; return d < 64 ? h * 64 + d : 512 + h * 64 + (d - 64); } };
struct MapRecIn { __device__ __forceinline__ int operator()(int c) const { return c < 1536 ? c : (c < 1568 ? 4096 + (c - 1536) : c - 32); } };

struct OrderShareB {
    int nMe, nNe, npairs, G, c; const int* AROWp;
    __device__ __forceinline__ const int* arow(const pg8::Unit& u) const { const int e = u.pm / nMe; return AROWp + e * MEXP + (u.pm - e * nMe) * 256; }
    __device__ __forceinline__ bool next(int i, pg8::Unit& u) const {
        long j; int x;
        if ((G & 7) == 0) { x = c & 7; j = (long)i * (G >> 3) + (c >> 3); } else { x = 0; j = -1; }
        int pair, pml;
        if (j >= 0) { pair = (int)(j / nMe) * 8 + x; pml = (int)(j % nMe); } else { const long L = (long)i * G + c; pair = (int)(L / nMe); pml = (int)(L % nMe); }
        if (pair >= npairs) return false;
        const int e = pair / nNe, pnl = pair - e * nNe; u.pm = e * nMe + pml; u.pn = e * nNe + pnl; u.ks = 0; return true;
    }
    __device__ __forceinline__ void a_ready(const pg8::Unit&) const {}
    __device__ __forceinline__ void done(const pg8::Unit&) const {}
};
struct OrderShareA {
    int nMe, nNe, npairs, G, c, nMl;
    __device__ __forceinline__ bool next(int i, pg8::Unit& u) const {
        long j; int x;
        if ((G & 7) == 0) { x = c & 7; j = (long)i * (G >> 3) + (c >> 3); } else { x = 0; j = -1; }
        int pair, pnl;
        if (j >= 0) { pair = (int)(j / nNe) * 8 + x; pnl = (int)(j % nNe); } else { const long L = (long)i * G + c; pair = (int)(L / nNe); pnl = (int)(L % nNe); }
        if (pair >= npairs) return false;
        const int e = pair / nMl, pml = pair - e * nMl; u.pm = e * nMe + pml; u.pn = e * nNe + pnl; u.ks = 0; return true;
    }
    __device__ __forceinline__ void a_ready(const pg8::Unit&) const {}
    __device__ __forceinline__ void done(const pg8::Unit&) const {}
};
struct OrderCtxSplitK {
    int G, c;
    __device__ __forceinline__ bool next(int i, pg8::Unit& u) const {
        const long L = (long)i * G + c; if (L >= 256) return false;
        const int e = (int)L >> 4, rem = (int)L & 15; u.pm = e * 9 + 8; u.pn = e * 4 + (rem >> 2); u.ks = rem & 3; return true;
    }
    __device__ __forceinline__ int kofs(const pg8::Unit& u) const { return u.ks * 384; }
    __device__ __forceinline__ int klen(const pg8::Unit& u) const { return u.ks < 3 ? 384 : 256; }
    __device__ __forceinline__ void a_ready(const pg8::Unit&) const {}
    __device__ __forceinline__ void done(const pg8::Unit&) const {}
};
struct LatentOrder : pg8::StaticOrder {
    __device__ __forceinline__ bool next(int i, pg8::Unit& u) const { if (!pg8::StaticOrder::next(i, u)) return false; u.pm = (u.pm >> 3) * 9 + 1 + (u.pm & 7); return true; }
};


struct OrderCtxSplitK4 {
    int G, c;
    __device__ __forceinline__ bool next(int i, pg8::Unit& u) const {
        const long L = (long)i * G + c; if (L >= 128) return false;
        const int b = (int)L >> 4, rem = (int)L & 15; u.pm = b * 9; u.pn = rem >> 2; u.ks = rem & 3; return true;
    }
    __device__ __forceinline__ int kofs(const pg8::Unit& u) const { return u.ks * 256; }
    __device__ __forceinline__ int klen(const pg8::Unit&) const { return 256; }
    __device__ __forceinline__ void a_ready(const pg8::Unit&) const {}
    __device__ __forceinline__ void done(const pg8::Unit&) const {}
};

__device__ __forceinline__ u32x4_t pack8(f32x4 a0, f32x4 a1, float s);
struct EpiSwiGLU {
    static constexpr bool PERM = true, AFTER_DRAIN = false;
    unsigned char* HID; int nMe;
    __device__ __forceinline__ void operator()(const f32x4 (&acc)[2][2][4][2], const pg8::Unit& u, int wr, int wc, int fr, int fq) const {
        const int e = u.pm / nMe, pnl = u.pn - e * 22;
        const int row0 = u.pm * 256 + wr * 64 + fr, col0 = pnl * 128 + wc * 32 + 8 * fq;
#pragma unroll
        for (int ai = 0; ai < 2; ++ai)
#pragma unroll
            for (int m = 0; m < 4; ++m) {
                const f32x4 g0 = acc[ai][0][m][0], g1 = acc[ai][0][m][1], u0 = acc[ai][1][m][0], u1 = acc[ai][1][m][1];
                float hv[8];
#pragma unroll
                for (int j = 0; j < 4; ++j) {
                    const float r0 = __builtin_amdgcn_rcpf(fmaf(__builtin_amdgcn_exp2f(g0[j] * (-W8_INV * 1.44269504f)), 4096.f, 4096.f)), r1 = __builtin_amdgcn_rcpf(fmaf(__builtin_amdgcn_exp2f(g1[j] * (-W8_INV * 1.44269504f)), 4096.f, 4096.f));
                    hv[j] = __builtin_amdgcn_fmed3f(g0[j] * u0[j] * r0, -448.f, 448.f); hv[4 + j] = __builtin_amdgcn_fmed3f(g1[j] * u1[j] * r1, -448.f, 448.f); }
                u32x2_t w; w.x = pk4_fp8(hv[0], hv[1], hv[2], hv[3]); w.y = pk4_fp8(hv[4], hv[5], hv[6], hv[7]);
                *(u32x2_t*)(HID + (size_t)(row0 + ai * 128 + m * 16) * FF + col0) = w; }
    }
};
struct EpiDownGate {
    static constexpr bool PERM = true, AFTER_DRAIN = false;
    bf16_t* Y; const float* GATE; int nMe;
    __device__ __forceinline__ void operator()(const f32x4 (&acc)[2][2][4][2], const pg8::Unit& u, int wr, int wc, int fr, int fq) const {
        const int e = u.pm / nMe, pnl = u.pn - e * 4, ml0 = (u.pm - e * nMe) * 256 + wr * 64 + fr;
        const int row0 = u.pm * 256 + wr * 64 + fr, col0 = pnl * 256 + wc * 32 + 8 * fq;
        float gts[2][4];
#pragma unroll
        for (int ai = 0; ai < 2; ++ai)
#pragma unroll
            for (int m = 0; m < 4; ++m) gts[ai][m] = GATE[e * MEXP + ml0 + ai * 128 + m * 16] * W8_INV;
#pragma unroll
        for (int ai = 0; ai < 2; ++ai)
#pragma unroll
            for (int m = 0; m < 4; ++m) { const float gt = gts[ai][m]; bf16_t* rowp = Y + (size_t)(row0 + ai * 128 + m * 16) * D + col0;
#pragma unroll
                for (int bj = 0; bj < 2; ++bj) *(u32x4_t*)(rowp + bj * 128) = pack8(acc[ai][bj][m][0], acc[ai][bj][m][1], gt); }
    }
};
struct EpiDownCtxPart {
    static constexpr bool PERM = true, AFTER_DRAIN = false;
    bf16_t* Y2; const float* GATE;
    __device__ __forceinline__ void operator()(const f32x4 (&acc)[2][2][4][2], const pg8::Unit& u, int wr, int wc, int fr, int fq) const {
        const int e = u.pm / 9, pnl = u.pn - e * 4, ml0 = wr * 64 + fr, col0 = pnl * 256 + wc * 32 + 8 * fq;
        bf16_t* base = Y2 + ((size_t)u.ks * NE + e) * 256 * D;
        const float* gbase = GATE + e * MEXP + 2048;
#pragma unroll
        for (int ai = 0; ai < 2; ++ai)
#pragma unroll
            for (int m = 0; m < 4; ++m) { const int sl = ml0 + ai * 128 + m * 16; const float gt = gbase[sl] * W8_INV;
                const unsigned off = (unsigned)(sl * D + col0);
#pragma unroll
                for (int bj = 0; bj < 2; ++bj) *(u32x4_t*)(base + off + bj * 128) = pack8(acc[ai][bj][m][0], acc[ai][bj][m][1], gt);
                asm volatile("" ::: "memory"); }
    }
};
struct EpiCtxPart {
    static constexpr bool PERM = true, AFTER_DRAIN = false;
    bf16_t* CP;
    __device__ __forceinline__ void operator()(const f32x4 (&acc)[2][2][4][2], const pg8::Unit& u, int wr, int wc, int fr, int fq) const {
        const int b = u.pm / 9, ml0 = wr * 64 + fr, col0 = u.pn * 256 + wc * 32 + 8 * fq;
        bf16_t* base = CP + ((size_t)u.ks * NB + b) * 256 * D;
#pragma unroll
        for (int ai = 0; ai < 2; ++ai)
#pragma unroll
            for (int m = 0; m < 4; ++m) { const unsigned off = (unsigned)((ml0 + ai * 128 + m * 16) * D + col0);
#pragma unroll
                for (int bj = 0; bj < 2; ++bj) *(u32x4_t*)(base + off + bj * 128) = pack8(acc[ai][bj][m][0], acc[ai][bj][m][1], 1.f);
                asm volatile("" ::: "memory"); }
    }
};
__device__ __forceinline__ u32x4_t rope8(f32x4 a0, f32x4 a1, const float2* tb, float s) {
    const f32x4 t0 = *(const f32x4*)tb, t1 = *(const f32x4*)(tb + 2);
    u32x4_t w;
    w.x = pk_bf16((a0[0] * t0[0] - a0[1] * t0[1]) * s, (a0[1] * t0[0] + a0[0] * t0[1]) * s);
    w.y = pk_bf16((a0[2] * t0[2] - a0[3] * t0[3]) * s, (a0[3] * t0[2] + a0[2] * t0[3]) * s);
    w.z = pk_bf16((a1[0] * t1[0] - a1[1] * t1[1]) * s, (a1[1] * t1[0] + a1[0] * t1[1]) * s);
    w.w = pk_bf16((a1[2] * t1[2] - a1[3] * t1[3]) * s, (a1[3] * t1[2] + a1[2] * t1[3]) * s);
    return w;
}
__device__ __forceinline__ u32x4_t pack8(f32x4 a0, f32x4 a1, float s) {
    u32x4_t w; w.x = pk_bf16(a0[0] * s, a0[1] * s); w.y = pk_bf16(a0[2] * s, a0[3] * s); w.z = pk_bf16(a1[0] * s, a1[1] * s); w.w = pk_bf16(a1[2] * s, a1[3] * s); return w;
}
struct EpiAttnIn {
    static constexpr bool PERM = true, AFTER_DRAIN = false;
    bf16_t *QK, *V1, *CQ, *CKV, *KR; float* SSQ; const float2* RDA; const float2* RR;
    __device__ __forceinline__ void operator()(const f32x4 (&acc)[2][2][4][2], const pg8::Unit& u, int wr, int wc, int fr, int fq) const {
        const int rowb = u.pm * 256 + wr * 64 + fr, tpb = (u.pm % 9) * 256 + wr * 64 + fr, lc = wc * 32 + 8 * fq;
#pragma unroll
        for (int bj = 0; bj < 2; ++bj) {
            const int hidx = 2 * u.pn + bj;
            if (hidx < 8) {
                const float qs = hidx < 4 ? QS_DA : 1.f; const int i0 = (lc & 63) >> 1;
#pragma unroll
                for (int ai = 0; ai < 2; ++ai)
#pragma unroll
                    for (int m = 0; m < 4; ++m) { const int ro = ai * 128 + m * 16;
                        *(u32x4_t*)(QK + (size_t)(rowb + ro) * 1024 + hidx * 128 + lc) = rope8(acc[ai][bj][m][0], acc[ai][bj][m][1], RDA + (size_t)(tpb + ro) * 32 + i0, qs); }
            } else if (hidx < 12) {
#pragma unroll
                for (int ai = 0; ai < 2; ++ai)
#pragma unroll
                    for (int m = 0; m < 4; ++m) { const int ro = ai * 128 + m * 16;
                        *(u32x4_t*)(V1 + (size_t)(rowb + ro) * 512 + (hidx - 8) * 128 + lc) = pack8(acc[ai][bj][m][0], acc[ai][bj][m][1], 1.f); }
            } else if (hidx < 17) {
                const int which = hidx >= 15 ? 1 : 0;
#pragma unroll
                for (int ai = 0; ai < 2; ++ai)
#pragma unroll
                    for (int m = 0; m < 4; ++m) { const int ro = ai * 128 + m * 16; const f32x4 a0 = acc[ai][bj][m][0], a1 = acc[ai][bj][m][1];
                        bf16_t* dst = which ? CKV + (size_t)(rowb + ro) * 256 + (hidx - 15) * 128 + lc : CQ + (size_t)(rowb + ro) * 384 + (hidx - 12) * 128 + lc;
                        *(u32x4_t*)dst = pack8(a0, a1, 1.f);
                        float ss = (a0[0] * a0[0] + a0[1] * a0[1]) + (a0[2] * a0[2] + a0[3] * a0[3]) + (a1[0] * a1[0] + a1[1] * a1[1]) + (a1[2] * a1[2] + a1[3] * a1[3]);
                        ss += __shfl_xor(ss, 16); ss += __shfl_xor(ss, 32);
                        if (fq == 0) SSQ[(size_t)(rowb + ro) * 20 + (hidx - 12) * 4 + wc] = ss; }
            } else if (hidx == 17) {
                if (wc == 0) {
#pragma unroll
                    for (int ai = 0; ai < 2; ++ai)
#pragma unroll
                        for (int m = 0; m < 4; ++m) { const int ro = ai * 128 + m * 16;
                            *(u32x4_t*)(KR + (size_t)(rowb + ro) * 32 + lc) = rope8(acc[ai][bj][m][0], acc[ai][bj][m][1], RR + (size_t)(tpb + ro) * 16 + (lc >> 1), 1.f); }
                }
            }
        }
    }
};
struct EpiMlaQ {
    static constexpr bool PERM = true, AFTER_DRAIN = false;
    bf16_t* QM; const float* SSQ; const float2* RR;
    __device__ __forceinline__ void operator()(const f32x4 (&acc)[2][2][4][2], const pg8::Unit& u, int wr, int wc, int fr, int fq) const {
        const int rowb = u.pm * 256 + wr * 64 + fr, tpb = (u.pm % 9) * 256 + wr * 64 + fr, lc = wc * 32 + 8 * fq;
#pragma unroll
        for (int ai = 0; ai < 2; ++ai)
#pragma unroll
            for (int m = 0; m < 4; ++m) { const int ro = ai * 128 + m * 16;
                const f32x4* sp = (const f32x4*)(SSQ + (size_t)(rowb + ro) * 20); const f32x4 s0 = sp[0], s1 = sp[1], s2 = sp[2];
                const float ssq = ((s0[0] + s0[1]) + (s0[2] + s0[3])) + ((s1[0] + s1[1]) + (s1[2] + s1[3])) + ((s2[0] + s2[1]) + (s2[2] + s2[3]));
                const float rs = QS_MLA * __builtin_amdgcn_rsqf(ssq * (1.f / 384.f) + EPS);
#pragma unroll
                for (int bj = 0; bj < 2; ++bj) { const int hidx = 2 * u.pn + bj;
                    bf16_t* dst = QM + (size_t)(rowb + ro) * 768 + hidx * 128 + lc;
                    if (hidx < 4) *(u32x4_t*)dst = pack8(acc[ai][bj][m][0], acc[ai][bj][m][1], rs);
                    else *(u32x4_t*)dst = rope8(acc[ai][bj][m][0], acc[ai][bj][m][1], RR + (size_t)(tpb + ro) * 16 + ((lc & 31) >> 1), rs); }
                asm volatile("" ::: "memory"); }
    }
};
struct EpiMlaKV {
    static constexpr bool PERM = true, AFTER_DRAIN = false;
    bf16_t* KVM; const float* SSQ;
    __device__ __forceinline__ void operator()(const f32x4 (&acc)[2][2][4][2], const pg8::Unit& u, int wr, int wc, int fr, int fq) const {
        const int rowb = u.pm * 256 + wr * 64 + fr, lc = wc * 32 + 8 * fq;
#pragma unroll
        for (int ai = 0; ai < 2; ++ai)
#pragma unroll
            for (int m = 0; m < 4; ++m) { const int ro = ai * 128 + m * 16;
                const f32x4* sp = (const f32x4*)(SSQ + (size_t)(rowb + ro) * 20); const f32x4 s3 = sp[3], s4 = sp[4];
                const float ssq = ((s3[0] + s3[1]) + (s3[2] + s3[3])) + ((s4[0] + s4[1]) + (s4[2] + s4[3]));
                const float rs = __builtin_amdgcn_rsqf(ssq * (1.f / 256.f) + EPS);
#pragma unroll
                for (int bj = 0; bj < 2; ++bj) *(u32x4_t*)(KVM + (size_t)(rowb + ro) * 1024 + u.pn * 256 + bj * 128 + lc) = pack8(acc[ai][bj][m][0], acc[ai][bj][m][1], rs);
                asm volatile("" ::: "memory"); }
    }
};
template <bool FROM_INPUT>
struct EpiResid2 {
    static constexpr bool PERM = true, AFTER_DRAIN = false;
    bf16_t* X; const float* MODL;
    const float* xin; const float* ctxin;
    __device__ __forceinline__ void operator()(const f32x4 (&acc)[2][2][4][2], const pg8::Unit& u, int wr, int wc, int fr, int fq) const {
        const int b = u.pm / 9, jt = u.pm - b * 9, mi = jt == 0 ? 8 : b;
        const int row0 = u.pm * 256 + wr * 64 + fr, col0 = u.pn * 256 + wc * 32 + 8 * fq;
        const float* src = FROM_INPUT ? (jt == 0 ? ctxin + (size_t)b * CTX * D : xin + ((size_t)b * SEQ + (jt - 1) * 256) * D) + (size_t)(wr * 64 + fr) * D + col0 : nullptr;
        const float* gate = MODL + mi * 6144 + 2 * 1024 + col0;
        f32x4 gv[2][2];
#pragma unroll
        for (int bj = 0; bj < 2; ++bj)
#pragma unroll
            for (int n = 0; n < 2; ++n) gv[bj][n] = *(const f32x4*)(gate + bj * 128 + n * 4);
#pragma unroll
        for (int ai = 0; ai < 2; ++ai)
#pragma unroll
            for (int m = 0; m < 4; ++m) { bf16_t* rowp = X + (size_t)(row0 + ai * 128 + m * 16) * D + col0;
                f32x4 r0[2], r1[2];
#pragma unroll
                for (int bj = 0; bj < 2; ++bj) {
                    if (FROM_INPUT) { const float* s = src + (size_t)(ai * 128 + m * 16) * D + bj * 128; r0[bj] = *(const f32x4*)s; r1[bj] = *(const f32x4*)(s + 4); }
                    else { const u32x4_t w = *(const u32x4_t*)(rowp + bj * 128);
                        r0[bj] = (f32x4){__builtin_bit_cast(float, w.x << 16), __builtin_bit_cast(float, w.x & 0xffff0000u), __builtin_bit_cast(float, w.y << 16), __builtin_bit_cast(float, w.y & 0xffff0000u)};
                        r1[bj] = (f32x4){__builtin_bit_cast(float, w.z << 16), __builtin_bit_cast(float, w.z & 0xffff0000u), __builtin_bit_cast(float, w.w << 16), __builtin_bit_cast(float, w.w & 0xffff0000u)}; } }
#pragma unroll
                for (int bj = 0; bj < 2; ++bj) *(u32x4_t*)(rowp + bj * 128) = pack8(r0[bj] + gv[bj][0] * acc[ai][bj][m][0], r1[bj] + gv[bj][1] * acc[ai][bj][m][1], 1.f); }
    }
};
struct EpiRecIn {
    static constexpr bool PERM = true, AFTER_DRAIN = false;
    bf16_t* RB; bf16_t* LF; float* GD; const float* LB1;
    __device__ __forceinline__ void operator()(const f32x4 (&acc)[2][2][4][2], const pg8::Unit& u, int wr, int wc, int fr, int fq) const {
        const int rowb = u.pm * 256 + wr * 64 + fr, lc = wc * 32 + 8 * fq;
#pragma unroll
        for (int bj = 0; bj < 2; ++bj) {
            const int hidx = 2 * u.pn + bj;
            if (hidx < 16 || (hidx >= 24 && hidx < 32)) {
                const bool act = (hidx >= 8 && hidx < 16) || hidx >= 28; const float s = hidx < 2 ? 0.125f : 1.f;
                const int dcol = (hidx < 16 ? hidx : hidx - 8) * 128 + lc;
#pragma unroll
                for (int ai = 0; ai < 2; ++ai)
#pragma unroll
                    for (int m = 0; m < 4; ++m) { const int ro = ai * 128 + m * 16; f32x4 a0 = acc[ai][bj][m][0], a1 = acc[ai][bj][m][1];
                        if (act) {
#pragma unroll
                            for (int j = 0; j < 4; ++j) { a0[j] = fast_silu(a0[j]); a1[j] = fast_silu(a1[j]); } }
                        *(u32x4_t*)(RB + (size_t)(rowb + ro) * 3072 + dcol) = pack8(a0, a1, s); }
            } else if (hidx < 24) {
                const int cp = (hidx - 16) * 128 + lc;
                const f32x4 l0 = *(const f32x4*)(LB1 + cp), l1 = *(const f32x4*)(LB1 + cp + 4);
#pragma unroll
                for (int ai = 0; ai < 2; ++ai)
#pragma unroll
                    for (int m = 0; m < 4; ++m) { const int ro = ai * 128 + m * 16; f32x4 a0 = acc[ai][bj][m][0], a1 = acc[ai][bj][m][1];
#pragma unroll
                        for (int j = 0; j < 4; ++j) { a0[j] = logf(l0[j] + (1.f - l0[j]) * sigmoidf(a0[j])); a1[j] = logf(l1[j] + (1.f - l1[j]) * sigmoidf(a1[j])); }
                        *(u32x4_t*)(LF + (size_t)(rowb + ro) * 1024 + cp) = pack8(a0, a1, 1.f); }
            } else if (hidx == 32) {
                if (wc == 0) {
#pragma unroll
                    for (int ai = 0; ai < 2; ++ai)
#pragma unroll
                        for (int m = 0; m < 4; ++m) { const int ro = ai * 128 + m * 16; float* dst = GD + (size_t)(rowb + ro) * 32 + lc; *(f32x4*)dst = acc[ai][bj][m][0]; *(f32x4*)(dst + 4) = acc[ai][bj][m][1]; }
                }
            }
        }
    }
};

typedef float f32x16 __attribute__((ext_vector_type(16)));
typedef short bf16x8_t __attribute__((ext_vector_type(8)));
typedef __bf16 bf16x2v_t __attribute__((ext_vector_type(2)));
typedef float f32x2v_t __attribute__((ext_vector_type(2)));
__device__ __forceinline__ unsigned cvtpk_c(float lo, float hi) { const f32x2v_t v = {lo, hi}; const bf16x2v_t b = __builtin_convertvector(v, bf16x2v_t); return __builtin_bit_cast(unsigned, b); }
template <int DQK, int DV, int MODE, bool CONV = false>
__device__ __forceinline__ void attn_unit_mfma(LAS unsigned char* lds, const bf16_t* q1, const bf16_t* q2, int ldq, const bf16_t* k1, int ldk1, const bf16_t* k2, int ldk2,
                                               const bf16_t* vp, int ldv, int qrow0, int krow0, int nk, bf16_t* obf, int ldob, float lam, const float* subg, float oscale, ConvCtx* cc = nullptr) {
    constexpr int KS = DQK / 16, NDV = DV / 32, KSTR = DQK * 2 + 16, VSTR = DV * 2 + 64, KT_BYTES = 64 * KSTR, BUF = KT_BYTES + 64 * VSTR;
    constexpr int KCH = DQK / 8, VCH = DV / 8, NCH = 64 * (KCH + VCH), PER = (NCH + NT - 1) / NT;
    const int tid = threadIdx.x, wave = tid >> 6, lane = tid & 63, r = lane & 31, h = lane >> 5;
    const bf16_t* gsrc[PER]; int grs[PER]; int loff[PER];
#pragma unroll
    for (int i = 0; i < PER; ++i) { const int idx = tid + NT * i;
        if (idx < 64 * KCH) { const int row = idx / KCH, ch = idx - row * KCH;
            if (ch < 8) { gsrc[i] = k1 + (size_t)row * ldk1 + ch * 8; grs[i] = ldk1; } else { gsrc[i] = k2 + (size_t)row * ldk2 + (ch - 8) * 8; grs[i] = ldk2; }
            loff[i] = row * KSTR + ch * 16; }
        else { const int j = (idx < NCH ? idx : NCH - 1) - 64 * KCH, row = j / VCH, ch = j - row * VCH; gsrc[i] = vp + (size_t)row * ldv + ch * 8; grs[i] = ldv; loff[i] = KT_BYTES + row * VSTR + ch * 16; } }
    bf16x8_t qf[KS];
    { const size_t qrow = (size_t)qrow0 + wave * 32 + r;
#pragma unroll
      for (int ks = 0; ks < KS; ++ks) qf[ks] = *(const bf16x8_t*)(ks < 4 ? q1 + qrow * ldq + 16 * ks + 8 * h : q2 + qrow * ldq + 16 * (ks - 4) + 8 * h); }
    f32x16 ot[NDV];
#pragma unroll
    for (int d = 0; d < NDV; ++d)
#pragma unroll
        for (int i = 0; i < 16; ++i) ot[d][i] = 0.f;
    float m = -INFINITY, l = 0.f;
    u32x4_t stg[PER];
    __syncthreads();
#pragma unroll
    for (int i = 0; i < PER; ++i) stg[i] = *(const u32x4_t*)(gsrc[i] + (size_t)krow0 * grs[i]);
#pragma unroll
    for (int i = 0; i < PER; ++i) if (tid + NT * i < NCH) *(LAS u32x4_t*)(lds + loff[i]) = stg[i];
    __syncthreads();
    const int kaddr = r * KSTR + 16 * h;
    const int g = lane >> 4, q4 = (lane >> 2) & 3, p4 = lane & 3;
    const int vaddr = KT_BYTES + (4 * (g >> 1) + q4) * VSTR + (16 * (g & 1) + 4 * p4) * 2;
    ConvItem cit{}; bool cact = false; float4 cv[8];
    LAS unsigned char* cscr = lds + 61440 + __builtin_amdgcn_readfirstlane(wave) * 10240;
    for (int kt = 0; kt < nk; kt += 64) {
        const int buf = ((kt >> 6) & 1) * BUF;
        const bool more = kt + 64 < nk;
        if (more) {
#pragma unroll
            for (int i = 0; i < PER; ++i) stg[i] = *(const u32x4_t*)(gsrc[i] + (size_t)(krow0 + kt + 64) * grs[i]);
        }
        if constexpr (CONV) {
            const int ti = kt >> 6, cq = ti & 1;
            if (cact) { if (ti > 0) conv_q_stash((ti - 1) & 1, cv, cscr, lane); if (cq == 0) conv_finish(cit, cscr, lane); }
            if (cq == 0) { const int item = conv_item_index(*cc, cc->n); cact = item < conv_att_limit(*cc) && kt + 128 <= nk;
                if (cact) { cit = conv_decode_l1(*cc, item); cc->n += 1; } }
            if (cact) conv_q_issue(cit, cq, cv, lane);
        }
        f32x16 st[2];
        __builtin_amdgcn_s_setprio(1);
#pragma unroll
        for (int kb = 0; kb < 2; ++kb) {
#pragma unroll
            for (int i = 0; i < 16; ++i) st[kb][i] = 0.f;
            bf16x8_t kf[KS];
#pragma unroll
            for (int ks = 0; ks < KS; ++ks) kf[ks] = *(const LAS bf16x8_t*)(lds + buf + kb * 32 * KSTR + kaddr + 32 * ks);
            __builtin_amdgcn_sched_barrier(0);
#pragma unroll
            for (int ks = 0; ks < KS; ++ks) st[kb] = __builtin_amdgcn_mfma_f32_32x32x16_bf16(kf[ks], qf[ks], st[kb], 0, 0, 0);
        }
        __builtin_amdgcn_s_setprio(0);
        float tmax = fmaxf(st[0][0], st[1][0]);
#pragma unroll
        for (int i = 1; i < 16; ++i) tmax = fmaxf(tmax, fmaxf(st[0][i], st[1][i]));
        tmax = fmaxf(tmax, __shfl_xor(tmax, 32));
        const float mn = fmaxf(m, tmax), alpha = __builtin_amdgcn_exp2f(m - mn);
        m = mn;
        float ps = 0.f;
#pragma unroll
        for (int kb = 0; kb < 2; ++kb)
#pragma unroll
            for (int i = 0; i < 16; ++i) { const float p = __builtin_amdgcn_exp2f(st[kb][i] - mn); st[kb][i] = p; ps += p; }
        l = l * alpha + ps;
        if (!__all(alpha == 1.f)) {
#pragma unroll
            for (int d = 0; d < NDV; ++d)
#pragma unroll
                for (int i = 0; i < 16; ++i) ot[d][i] *= alpha;
        }
#pragma unroll
        for (int kb = 0; kb < 2; ++kb)
#pragma unroll
            for (int s = 0; s < 2; ++s) {
                u32x4_t pw; pw.x = cvtpk_c(st[kb][8 * s], st[kb][8 * s + 1]); pw.y = cvtpk_c(st[kb][8 * s + 2], st[kb][8 * s + 3]);
                pw.z = cvtpk_c(st[kb][8 * s + 4], st[kb][8 * s + 5]); pw.w = cvtpk_c(st[kb][8 * s + 6], st[kb][8 * s + 7]);
                const bf16x8_t pf = __builtin_bit_cast(bf16x8_t, pw);
                bf16x8_t vf[NDV];
#pragma unroll
                for (int d = 0; d < NDV; ++d) {
                    LAS unsigned char* a = lds + buf + vaddr + (kb * 32 + 16 * s) * VSTR + d * 64;
                    const v4i16_t lo = __builtin_amdgcn_ds_read_tr16_b64_v4i16((LAS v4i16_t*)a), hi = __builtin_amdgcn_ds_read_tr16_b64_v4i16((LAS v4i16_t*)(a + 8 * VSTR));
                    vf[d] = __builtin_shufflevector(lo, hi, 0, 1, 2, 3, 4, 5, 6, 7);
                }
                __builtin_amdgcn_sched_barrier(0);
#pragma unroll
                for (int d = 0; d < NDV; ++d) ot[d] = __builtin_amdgcn_mfma_f32_32x32x16_bf16(vf[d], pf, ot[d], 0, 0, 0);
            }
        if (more) {
#pragma unroll
            for (int i = 0; i < PER; ++i) if (tid + NT * i < NCH) *(LAS u32x4_t*)(lds + (BUF - buf) + loff[i]) = stg[i];
        }
        __syncthreads();
    }
    if constexpr (CONV) { if (cact) { conv_q_stash(1, cv, cscr, lane); conv_finish(cit, cscr, lane); } }
    l += __shfl_xor(l, 32);
    const float inv = 1.f / l;
    const size_t orow = (size_t)qrow0 + wave * 32 + r;
    LAS unsigned* park = (LAS unsigned*)(lds + 61440 + wave * 8192);
    if constexpr (MODE == 1) {
#pragma unroll
        for (int d = 0; d < NDV; ++d)
#pragma unroll
            for (int p = 0; p < 8; ++p) park[(d * 8 + p) * 64 + lane] = cvtpk_c(ot[d][2 * p] * inv, ot[d][2 * p + 1] * inv);
    } else if constexpr (MODE == 2) {
        float ss = 0.f;
#pragma unroll
        for (int d = 0; d < NDV; ++d)
#pragma unroll
            for (int p = 0; p < 8; ++p) { const unsigned w = park[(d * 8 + p) * 64 + lane];
                const float a = __builtin_bit_cast(float, w << 16) - lam * (ot[d][2 * p] * inv), b2 = __builtin_bit_cast(float, w & 0xffff0000u) - lam * (ot[d][2 * p + 1] * inv);
                ot[d][2 * p] = a; ot[d][2 * p + 1] = b2; ss += a * a + b2 * b2; }
        ss += __shfl_xor(ss, 32);
        const float rstd = oscale / sqrtf(ss * (1.f / DV) + EPS);
#pragma unroll
        for (int d = 0; d < NDV; ++d)
#pragma unroll
            for (int gg = 0; gg < 4; ++gg) { const int dv = d * 32 + 8 * gg + 4 * h; const f32x4 g4 = *(const f32x4*)(subg + dv);
                u32x2_t w; w.x = cvtpk_c(ot[d][4 * gg] * rstd * g4[0], ot[d][4 * gg + 1] * rstd * g4[1]); w.y = cvtpk_c(ot[d][4 * gg + 2] * rstd * g4[2], ot[d][4 * gg + 3] * rstd * g4[3]);
                *(u32x2_t*)(obf + orow * ldob + dv) = w; }
    } else {
#pragma unroll
        for (int d = 0; d < NDV; ++d)
#pragma unroll
            for (int gg = 0; gg < 4; ++gg) { const int dv = d * 32 + 8 * gg + 4 * h;
                u32x2_t w; w.x = cvtpk_c(ot[d][4 * gg] * inv, ot[d][4 * gg + 1] * inv); w.y = cvtpk_c(ot[d][4 * gg + 2] * inv, ot[d][4 * gg + 3] * inv);
                *(u32x2_t*)(obf + orow * ldob + dv) = w; }
    }
}

constexpr int SC_V_OFF = 87040, SC_SEG_OFF = 107520, SC_RED_OFF = 109568, SC_GD_OFF = 110592, SC_GK_OFF = 118784;
constexpr int SC_VSTR = 320;
template <int KIND>
struct ScanPrep {
    static constexpr int DK = KIND ? 128 : 64, CPR = DK / 8, NCHK = 64 * CPR / NT, GS = DK + 4, NSEG = NT / DK, SEGL = 64 / NSEG;
    float q[NCHK][8], k[NCHK][8];
};
__device__ __forceinline__ u32x4_t pack8f(const float* v);
template <int KIND> struct ScanRaw { f32x4 l0[ScanPrep<KIND>::NCHK], l1[ScanPrep<KIND>::NCHK]; };
template <int KIND> struct ScanQK { u32x4_t qw[ScanPrep<KIND>::NCHK], kw[ScanPrep<KIND>::NCHK]; };
template <int KIND, int LAM = 0>
__device__ __forceinline__ void scan_issue_l(ScanRaw<KIND>& R, int d, int h, size_t row0, const bf16_t* LF, const float* gkb, const bf16_t* LA = nullptr) {
    constexpr int CPR = ScanPrep<KIND>::CPR, NCHK = ScanPrep<KIND>::NCHK;
    const int tid = threadIdx.x;
#pragma unroll
    for (int n = 0; n < NCHK; ++n) { const int e = tid + NT * n, tok = e / CPR, k0 = (e - tok * CPR) * 8;
        if (KIND == 0 && LAM == 2) { R.l0[n] = __builtin_bit_cast(f32x4, *(const u32x4_t*)(LA + ((row0 + tok) * 2 + d) * 256 + h * 64 + k0)); R.l1[n] = R.l0[n]; }
        else if (KIND == 1) { R.l0[n] = __builtin_bit_cast(f32x4, *(const u32x4_t*)(LF + (row0 + tok) * 1024 + d * 512 + h * 128 + k0)); R.l1[n] = R.l0[n]; }
        else { const float* src = gkb + d * 256 + h * 64 + k0; R.l0[n] = *(const f32x4*)src; R.l1[n] = *(const f32x4*)(src + 4); } }
}
template <int KIND>
__device__ __forceinline__ void scan_issue_qk(ScanQK<KIND>& Q, int h, size_t row0, const bf16_t* RB) {
    constexpr int CPR = ScanPrep<KIND>::CPR, NCHK = ScanPrep<KIND>::NCHK;
    const int tid = threadIdx.x;
#pragma unroll
    for (int n = 0; n < NCHK; ++n) { const int e = tid + NT * n, tok = e / CPR, k0 = (e - tok * CPR) * 8; const size_t row = row0 + tok;
        if (KIND == 1) { Q.qw[n] = *(const u32x4_t*)(RB + row * 3072 + 1536 + h * 128 + k0); Q.kw[n] = Q.qw[n]; }
        else { Q.qw[n] = *(const u32x4_t*)(RB + row * 3072 + h * 64 + k0); Q.kw[n] = *(const u32x4_t*)(RB + row * 3072 + 256 + h * 64 + k0); } }
}
template <int KIND, int LAM = 0>
__device__ __forceinline__ void scan_consume(ScanPrep<KIND>& P, const ScanRaw<KIND>& R, const ScanQK<KIND>& Q, LAS unsigned char* lds, int d, bf16_t* LAw = nullptr, size_t row0 = 0, int h = 0) {
    constexpr int CPR = ScanPrep<KIND>::CPR, NCHK = ScanPrep<KIND>::NCHK, GS = ScanPrep<KIND>::GS;
    const int tid = threadIdx.x;
    LAS float* G = (LAS float*)lds;
#pragma unroll
    for (int n = 0; n < NCHK; ++n) { const int e = tid + NT * n, tok = e / CPR, k0 = (e - tok * CPR) * 8;
        float la[8];
        if (KIND == 1 || LAM == 2) { const u32x4_t lw = __builtin_bit_cast(u32x4_t, R.l0[n]);
#pragma unroll
            for (int j = 0; j < 4; ++j) { la[2 * j] = __builtin_bit_cast(float, lw[j] << 16); la[2 * j + 1] = __builtin_bit_cast(float, lw[j] & 0xffff0000u); }
        } else {
#pragma unroll
            for (int j = 0; j < 4; ++j) { la[j] = R.l0[n][j]; la[4 + j] = R.l1[n][j]; }
        }
#pragma unroll
        for (int j = 0; j < 4; ++j) { P.q[n][2 * j] = __builtin_bit_cast(float, Q.qw[n][j] << 16); P.q[n][2 * j + 1] = __builtin_bit_cast(float, Q.qw[n][j] & 0xffff0000u); }
        if (KIND == 1) {
#pragma unroll
            for (int j = 0; j < 8; ++j) P.k[n][j] = (1.f - __expf(la[j]));
        } else {
            if (LAM != 2) {
            const LAS float* gd = (const LAS float*)(lds + SC_GD_OFF) + tok * 32 + d * 16; const LAS float* gk = (const LAS float*)(lds + SC_GK_OFF) + d * 1024 + k0;
#pragma unroll 2
            for (int kk = 0; kk < 16; ++kk) { const float gv = gd[kk]; const f32x4 w0 = *(const LAS f32x4*)(gk + kk * 64), w1 = *(const LAS f32x4*)(gk + kk * 64 + 4);
#pragma unroll
                for (int j = 0; j < 4; ++j) { la[j] = fmaf(gv, w0[j], la[j]); la[4 + j] = fmaf(gv, w1[j], la[4 + j]); } }
#pragma unroll
            for (int j = 0; j < 8; ++j) la[j] = (fminf(la[j], 0.f) - __logf(1.f + __expf(-fabsf(la[j])))) * (1.f / 16.f);
            if (LAM == 1) {
                const u32x4_t lw = pack8f(la); *(u32x4_t*)(LAw + ((row0 + tok) * 2 + d) * 256 + h * 64 + k0) = lw;
#pragma unroll
                for (int j = 0; j < 4; ++j) { la[2 * j] = __builtin_bit_cast(float, lw[j] << 16); la[2 * j + 1] = __builtin_bit_cast(float, lw[j] & 0xffff0000u); } }
            }
#pragma unroll
            for (int j = 0; j < 4; ++j) { P.k[n][2 * j] = __builtin_bit_cast(float, Q.kw[n][j] << 16); P.k[n][2 * j + 1] = __builtin_bit_cast(float, Q.kw[n][j] & 0xffff0000u); }
        }
        LAS float* gp = G + tok * GS + k0; *(LAS f32x4*)gp = (f32x4){la[0], la[1], la[2], la[3]}; *(LAS f32x4*)(gp + 4) = (f32x4){la[4], la[5], la[6], la[7]};
        asm volatile("" ::: "memory");
    }
}
template <int KIND>
__device__ __forceinline__ void scan_cumsum(LAS unsigned char* lds, int d) {
    constexpr int DK = ScanPrep<KIND>::DK, GS = ScanPrep<KIND>::GS, NSEG = ScanPrep<KIND>::NSEG, SEGL = ScanPrep<KIND>::SEGL;
    const int tid = threadIdx.x, k = tid % DK, sg = tid / DK;
    LAS float* G = (LAS float*)lds; LAS float* seg = (LAS float*)(lds + SC_SEG_OFF);
    __syncthreads();
    float run = 0.f;
#pragma unroll
    for (int p = 0; p < SEGL; ++p) { const int pp = sg * SEGL + p, tok = d ? 63 - pp : pp; run += G[tok * GS + k]; G[tok * GS + k] = run; }
    seg[sg * DK + k] = run;
    __syncthreads();
    float off = 0.f;
#pragma unroll
    for (int s2 = 0; s2 < NSEG; ++s2) off += (s2 < sg) ? seg[s2 * DK + k] : 0.f;
#pragma unroll
    for (int p = 0; p < SEGL; ++p) { const int pp = sg * SEGL + p, tok = d ? 63 - pp : pp; G[tok * GS + k] += off; }
    __syncthreads();
}
__device__ __forceinline__ u32x4_t pack8f(const float* v) { u32x4_t w; w.x = cvtpk_c(v[0], v[1]); w.y = cvtpk_c(v[2], v[3]); w.z = cvtpk_c(v[4], v[5]); w.w = cvtpk_c(v[6], v[7]); return w; }
__device__ __forceinline__ void scan_load_v(LAS unsigned char* lds, const bf16_t* vsrc  , int tid) {
#pragma unroll
    for (int n = 0; n < 2; ++n) { const int e = tid + NT * n, tok = e >> 4, ch = e & 15;
        *(LAS u32x4_t*)(lds + SC_V_OFF + tok * SC_VSTR + ch * 16) = *(const u32x4_t*)(vsrc + (size_t)tok * 3072 + ch * 8); }
}
__device__ __forceinline__ void scan_load_gla(LAS unsigned char* lds, const float* GD, size_t row0, const float* gkup, int h, int tid) {
    { const int tok = tid >> 3, c4 = (tid & 7) * 4; *(LAS f32x4*)(lds + SC_GD_OFF + (tok * 32 + c4) * 4) = *(const f32x4*)(GD + (row0 + tok) * 32 + c4); }
    { const int dk = tid >> 4, c4 = (tid & 15) * 4; *(LAS f32x4*)(lds + SC_GK_OFF + (dk * 64 + c4) * 4) = *(const f32x4*)(gkup + dk * 256 + h * 64 + c4); }
}

template <int KIND>
__device__ __forceinline__ void scan_s1_unit(LAS unsigned char* lds, int b, int h, int c, const bf16_t* RB, const bf16_t* LF, const float* GD, const float* gkup, const float* gkb, unsigned* KVT, float* DEC, bf16_t* LAw) {
    constexpr int DK = ScanPrep<KIND>::DK, CPR = ScanPrep<KIND>::CPR, NCHK = ScanPrep<KIND>::NCHK, GS = ScanPrep<KIND>::GS, TSR = DK * 2 + 64, KH_OFF = 34816, NKB = DK / 32;
    const int tid = threadIdx.x, wave = tid >> 6, lane = tid & 63;
    const size_t row0 = (size_t)b * TT + (c < 4 ? 64 * c : CTX + 64 * (c - 4));
    const int chain = (b * 2 + KIND) * 4 + h, ck = b * 4 + h;
    ScanPrep<KIND> P;
    ScanRaw<KIND> Rw[2]; ScanQK<KIND> Qw; u32x4_t vr[2]; f32x4 gla0, gla1;
    scan_issue_l<KIND>(Rw[0], 0, h, row0, LF, gkb); scan_issue_qk<KIND>(Qw, h, row0, RB);
    { const bf16_t* vsrc = RB + row0 * 3072 + (KIND ? 2048 : 512) + h * 128;
#pragma unroll
      for (int n = 0; n < 2; ++n) { const int e = tid + NT * n; vr[n] = *(const u32x4_t*)(vsrc + (size_t)(e >> 4) * 3072 + (e & 15) * 8); } }
    if (KIND == 0) { gla0 = *(const f32x4*)(GD + (row0 + (tid >> 3)) * 32 + (tid & 7) * 4); gla1 = *(const f32x4*)(gkup + (tid >> 4) * 256 + h * 64 + (tid & 15) * 4); }
    scan_issue_l<KIND>(Rw[1], 1, h, row0, LF, gkb);
    __syncthreads();
#pragma unroll
    for (int n = 0; n < 2; ++n) { const int e = tid + NT * n; *(LAS u32x4_t*)(lds + SC_V_OFF + (e >> 4) * SC_VSTR + (e & 15) * 16) = vr[n]; }
    if (KIND == 0) { *(LAS f32x4*)(lds + SC_GD_OFF + ((tid >> 3) * 32 + (tid & 7) * 4) * 4) = gla0; *(LAS f32x4*)(lds + SC_GK_OFF + ((tid >> 4) * 64 + (tid & 15) * 4) * 4) = gla1; __syncthreads(); }
    LAS float* G = (LAS float*)lds;
#pragma unroll
    for (int d = 0; d < 2; ++d) {
        scan_consume<KIND, 1>(P, Rw[d], Qw, lds, d, LAw, row0, h);
        scan_cumsum<KIND>(lds, d);
        const int tl = d ? 0 : 63;
        if (tid < DK) DEC[((size_t)(chain * 2 + d) * 36 + c) * 128 + tid] = __expf(G[tl * GS + tid]);
#pragma unroll
        for (int n = 0; n < NCHK; ++n) { const int e = tid + NT * n, tok = e / CPR, k0 = (e - tok * CPR) * 8;
            float kh[8];
#pragma unroll
            for (int j = 0; j < 8; ++j) kh[j] = P.k[n][j] * __expf(G[tl * GS + k0 + j] - G[tok * GS + k0 + j]);
            *(LAS u32x4_t*)(lds + KH_OFF + tok * TSR + k0 * 2) = pack8f(kh);
            asm volatile("" ::: "memory"); }
        __syncthreads();
        const int g = lane >> 4, q4 = (lane >> 2) & 3, p4 = lane & 3, r = lane & 31, hh = lane >> 5;
        const int dvb = wave & 3;
        unsigned* out = KVT + ((size_t)(ck * 2 + d) * 36 + c) * (128 * DK / 2);
#pragma unroll
        for (int t2 = 0; t2 < NKB / 2; ++t2) { const int kb = (wave >> 2) + 2 * t2;
            f32x16 acc;
#pragma unroll
            for (int i = 0; i < 16; ++i) acc[i] = 0.f;
#pragma unroll
            for (int s = 0; s < 4; ++s) {
                LAS unsigned char* va = lds + SC_V_OFF + (16 * s + 8 * (g >> 1) + q4) * SC_VSTR + (dvb * 32 + 16 * (g & 1) + 4 * p4) * 2;
                LAS unsigned char* ka = lds + KH_OFF + (16 * s + 8 * (g >> 1) + q4) * TSR + (kb * 32 + 16 * (g & 1) + 4 * p4) * 2;
                const v4i16_t v0 = __builtin_amdgcn_ds_read_tr16_b64_v4i16((LAS v4i16_t*)va), v1 = __builtin_amdgcn_ds_read_tr16_b64_v4i16((LAS v4i16_t*)(va + 4 * SC_VSTR));
                const v4i16_t k0v = __builtin_amdgcn_ds_read_tr16_b64_v4i16((LAS v4i16_t*)ka), k1v = __builtin_amdgcn_ds_read_tr16_b64_v4i16((LAS v4i16_t*)(ka + 4 * TSR));
                acc = __builtin_amdgcn_mfma_f32_32x32x16_bf16(__builtin_shufflevector(v0, v1, 0, 1, 2, 3, 4, 5, 6, 7), __builtin_shufflevector(k0v, k1v, 0, 1, 2, 3, 4, 5, 6, 7), acc, 0, 0, 0);
            }
#pragma unroll
            for (int p = 0; p < 8; ++p) out[((dvb * NKB + kb) * 8 + p) * 64 + lane] = cvtpk_c(acc[2 * p], acc[2 * p + 1]);
        }
    }
}

__device__ __forceinline__ void scan_s2(const unsigned* KVT0, const unsigned* KVT1, const float* DEC, bf16_t* SST0, bf16_t* SST1, int bid, int nb) {
    const size_t gtid = (size_t)bid * NT + threadIdx.x, gth = (size_t)nb * NT;
    constexpr size_t N0 = (size_t)32 * 2 * 1024, N1 = (size_t)32 * 2 * 2048;
    for (size_t it = gtid; it < N0 + N1; it += gth) {
        size_t r = it; int kind, DKk; const unsigned* KVT; bf16_t* SST;
        if (r < N0) { kind = 0; DKk = 64; KVT = KVT0; SST = SST0; } else { r -= N0; kind = 1; DKk = 128; KVT = KVT1; SST = SST1; }
        const int nv = 128 * DKk / 8, NKB = DKk / 32; const int cd = (int)(r / nv), v = (int)(r - (size_t)cd * nv); const int ck = cd >> 1, d = cd & 1;
        const int b = ck >> 2, h = ck & 3, chain = (b * 2 + kind) * 4 + h;
        const int t = v >> 7, rem = v & 127, p = rem >> 4, lg = rem & 15, hh = lg >> 3, dvb = t / NKB, kb = t - dvb * NKB;
        const int k0 = kb * 32 + ((4 * lg) & 31), dva = dvb * 32 + ((2 * p) & 3) + 8 * ((2 * p) >> 2) + 4 * hh;
        const unsigned* kv = KVT + ((size_t)(ck * 2 + d) * 36) * (128 * DKk / 2) + (t * 8 + p) * 64 + 4 * lg;
        const float* dc = DEC + ((size_t)(chain * 2 + d) * 36) * 128 + k0;
        bf16_t* ss = SST + ((size_t)(ck * 2 + d) * 32) * (128 * DKk) + (size_t)dva * DKk + k0;
        f32x4 Sa = {0.f, 0.f, 0.f, 0.f}, Sb = {0.f, 0.f, 0.f, 0.f};
#pragma unroll 1
        for (int g0 = 0; g0 < 36; g0 += 12) {
            f32x4 av[12]; u32x4_t uv[12];
#pragma unroll
            for (int j = 0; j < 12; ++j) { const int step = g0 + j, c = d ? (step < 4 ? 3 - step : 4 + (35 - step)) : step;
                av[j] = *(const f32x4*)(dc + (size_t)c * 128); uv[j] = *(const u32x4_t*)(kv + (size_t)c * (128 * DKk / 2)); }
#pragma unroll
            for (int j = 0; j < 12; ++j) { const int step = g0 + j, c = d ? (step < 4 ? 3 - step : 4 + (35 - step)) : step;
                if (c >= 4) { bf16_t* o = ss + (size_t)(c - 4) * (128 * DKk);
                    u32x2_t w; w.x = cvtpk_c(Sa[0], Sa[1]); w.y = cvtpk_c(Sa[2], Sa[3]); *(u32x2_t*)o = w;
                    w.x = cvtpk_c(Sb[0], Sb[1]); w.y = cvtpk_c(Sb[2], Sb[3]); *(u32x2_t*)(o + DKk) = w; }
                const u32x4_t u = uv[j];
                const f32x4 ua = {__builtin_bit_cast(float, u[0] << 16), __builtin_bit_cast(float, u[1] << 16), __builtin_bit_cast(float, u[2] << 16), __builtin_bit_cast(float, u[3] << 16)};
                const f32x4 ub = {__builtin_bit_cast(float, u[0] & 0xffff0000u), __builtin_bit_cast(float, u[1] & 0xffff0000u), __builtin_bit_cast(float, u[2] & 0xffff0000u), __builtin_bit_cast(float, u[3] & 0xffff0000u)};
                Sa = av[j] * Sa + ua; Sb = av[j] * Sb + ub; }
        }
    }
}

template <int KIND>
__device__ __forceinline__ void scan_s3_unit(LAS unsigned char* lds, int b, int h, int lc, const bf16_t* RB, const bf16_t* LF, const float* GD, const float* gkup, const float* gkb,
                                             const bf16_t* SST, const float* gn, bf16_t* R, const bf16_t* LA) {
    constexpr int DK = ScanPrep<KIND>::DK, CPR = ScanPrep<KIND>::CPR, NCHK = ScanPrep<KIND>::NCHK, GS = ScanPrep<KIND>::GS, KS = DK / 16, TS = DK * 2 + 16;
    constexpr int QT_OFF = 34816, KT_OFF = QT_OFF + 64 * 272, QH_OFF = KT_OFF + 64 * 272;
    const int tid = threadIdx.x, wave = tid >> 6, lane = tid & 63;
    const size_t row0 = (size_t)b * TT + CTX + 64 * lc;
    const int ck = b * 4 + h;
    ScanPrep<KIND> P;
    const int g = lane >> 4, q4 = (lane >> 2) & 3, p4 = lane & 3, r = lane & 31, hh = lane >> 5, dvb = wave & 3, ib = wave >> 2;
    ScanRaw<KIND> Rw[2]; ScanQK<KIND> Qw; bf16x8_t sfs[2][KS]; u32x4_t vr[2]; u32x2_t gwr[4];
    scan_issue_l<KIND, 2>(Rw[0], 0, h, row0, LF, gkb, LA); scan_issue_qk<KIND>(Qw, h, row0, RB);
    { const bf16_t* vsrc = RB + row0 * 3072 + (KIND ? 2048 : 512) + h * 128;
#pragma unroll
      for (int n = 0; n < 2; ++n) { const int e = tid + NT * n; vr[n] = *(const u32x4_t*)(vsrc + (size_t)(e >> 4) * 3072 + (e & 15) * 8); } }
#pragma unroll
    for (int d = 0; d < 2; ++d) { const bf16_t* sp = SST + ((size_t)(ck * 2 + d) * 32 + lc) * (128 * DK) + (size_t)(dvb * 32 + r) * DK + 8 * hh;
#pragma unroll
        for (int ks = 0; ks < KS; ++ks) sfs[d][ks] = *(const bf16x8_t*)(sp + 16 * ks); }
    scan_issue_l<KIND, 2>(Rw[1], 1, h, row0, LF, gkb, LA);
#pragma unroll
    for (int gg = 0; gg < 4; ++gg) gwr[gg] = *(const u32x2_t*)(RB + (row0 + ib * 32 + r) * 3072 + (KIND ? 2560 : 1024) + h * 128 + dvb * 32 + 8 * gg + 4 * hh);
    __syncthreads();
#pragma unroll
    for (int n = 0; n < 2; ++n) { const int e = tid + NT * n; *(LAS u32x4_t*)(lds + SC_V_OFF + (e >> 4) * SC_VSTR + (e & 15) * 16) = vr[n]; }
    LAS float* G = (LAS float*)lds;
    f32x16 ot;
#pragma unroll
    for (int i = 0; i < 16; ++i) ot[i] = 0.f;
#pragma unroll
    for (int d = 0; d < 2; ++d) {
        scan_consume<KIND, 2>(P, Rw[d], Qw, lds, d);
        scan_cumsum<KIND>(lds, d);
#pragma unroll
        for (int n = 0; n < NCHK; ++n) { const int e = tid + NT * n, tok = e / CPR, k0 = (e - tok * CPR) * 8;
            float qt[8], kt[8], qh[8];
#pragma unroll
            for (int j = 0; j < 8; ++j) { const float gi = G[tok * GS + k0 + j], gr = G[32 * GS + k0 + j]; const float eq = __expf(gi - gr);
                qt[j] = P.q[n][j] * eq; kt[j] = P.k[n][j] * __expf(gr - gi); qh[j] = P.q[n][j] * __expf(gi); }
            *(LAS u32x4_t*)(lds + QT_OFF + tok * TS + k0 * 2) = pack8f(qt); *(LAS u32x4_t*)(lds + KT_OFF + tok * TS + k0 * 2) = pack8f(kt); *(LAS u32x4_t*)(lds + QH_OFF + tok * TS + k0 * 2) = pack8f(qh);
            asm volatile("" ::: "memory"); }
        __syncthreads();
#pragma unroll
        for (int ks = 0; ks < KS; ++ks) { const bf16x8_t qf = *(const LAS bf16x8_t*)(lds + QH_OFF + (ib * 32 + r) * TS + 32 * ks + 16 * hh);
            ot = __builtin_amdgcn_mfma_f32_32x32x16_bf16(sfs[d][ks], qf, ot, 0, 0, 0); }
#pragma unroll
        for (int jb = 0; jb < 2; ++jb) {
            if (d == 0 ? (jb > ib) : (jb < ib)) continue;
            f32x16 st;
#pragma unroll
            for (int i = 0; i < 16; ++i) st[i] = 0.f;
#pragma unroll
            for (int ks = 0; ks < KS; ++ks) { const bf16x8_t kf = *(const LAS bf16x8_t*)(lds + KT_OFF + (jb * 32 + r) * TS + 32 * ks + 16 * hh), qf = *(const LAS bf16x8_t*)(lds + QT_OFF + (ib * 32 + r) * TS + 32 * ks + 16 * hh);
                st = __builtin_amdgcn_mfma_f32_32x32x16_bf16(kf, qf, st, 0, 0, 0); }
            if (jb == ib) {
#pragma unroll
                for (int i = 0; i < 16; ++i) { const int jl = (i & 3) + 8 * (i >> 2) + 4 * hh; const bool keep = d == 0 ? (jl <= r) : (jl >= r); st[i] = keep ? st[i] : 0.f; }
            }
#pragma unroll
            for (int s = 0; s < 2; ++s) {
                u32x4_t pw; pw.x = cvtpk_c(st[8 * s], st[8 * s + 1]); pw.y = cvtpk_c(st[8 * s + 2], st[8 * s + 3]); pw.z = cvtpk_c(st[8 * s + 4], st[8 * s + 5]); pw.w = cvtpk_c(st[8 * s + 6], st[8 * s + 7]);
                LAS unsigned char* va = lds + SC_V_OFF + (jb * 32 + 16 * s + 4 * (g >> 1) + q4) * SC_VSTR + (dvb * 32 + 16 * (g & 1) + 4 * p4) * 2;
                const v4i16_t v0 = __builtin_amdgcn_ds_read_tr16_b64_v4i16((LAS v4i16_t*)va), v1 = __builtin_amdgcn_ds_read_tr16_b64_v4i16((LAS v4i16_t*)(va + 8 * SC_VSTR));
                ot = __builtin_amdgcn_mfma_f32_32x32x16_bf16(__builtin_shufflevector(v0, v1, 0, 1, 2, 3, 4, 5, 6, 7), __builtin_bit_cast(bf16x8_t, pw), ot, 0, 0, 0);
            }
        }
    }
    float ss = 0.f;
#pragma unroll
    for (int i = 0; i < 16; ++i) ss += ot[i] * ot[i];
    ss += __shfl_xor(ss, 32);
    LAS float* red = (LAS float*)(lds + SC_RED_OFF);
    if (hh == 0) red[wave * 32 + r] = ss;
    __syncthreads();
    const float tot = red[(ib * 4 + 0) * 32 + r] + red[(ib * 4 + 1) * 32 + r] + red[(ib * 4 + 2) * 32 + r] + red[(ib * 4 + 3) * 32 + r];
    const float rstd = 1.f / sqrtf(tot * (1.f / 128.f) + EPS);
    const size_t row = row0 + ib * 32 + r;
#pragma unroll
    for (int gg = 0; gg < 4; ++gg) { const int dv = dvb * 32 + 8 * gg + 4 * hh;
        const f32x4 gv = *(const f32x4*)(gn + dv);
        const u32x2_t gw = gwr[gg];
        const float g0 = __builtin_bit_cast(float, gw.x << 16), g1 = __builtin_bit_cast(float, gw.x & 0xffff0000u), g2 = __builtin_bit_cast(float, gw.y << 16), g3 = __builtin_bit_cast(float, gw.y & 0xffff0000u);
        u32x2_t w; w.x = cvtpk_c(ot[4 * gg] * rstd * gv[0] * g0, ot[4 * gg + 1] * rstd * gv[1] * g1); w.y = cvtpk_c(ot[4 * gg + 2] * rstd * gv[2] * g2, ot[4 * gg + 3] * rstd * gv[3] * g3);
        *(u32x2_t*)(R + row * D + KIND * 512 + h * 128 + dv) = w; }
}

struct Args { const float* in[31]; float* out; unsigned char* ws; int ph_lo, ph_hi; };
enum { I_X = 0, I_C, I_CTX, I_CCTX, I_ADAW, I_ADAB, I_N1G, I_N2G, I_ATTWIN, I_QNG, I_QUP, I_KVNG, I_KVUP, I_LQ1, I_LK1, I_LQ2, I_LK2, I_SUBLN, I_ATTWOUT,
       I_RECWIN, I_GKUP, I_GKB, I_GLANG, I_LBL, I_HGNG, I_RECWOUT, I_ROUTER, I_WG, I_WU, I_WD, I_FNG };
constexpr int N_PHASES = 26;

__device__ __forceinline__ void phase_norm1(const float* xin, const float* ctxin, bf16_t* H, const float* g, const float* MODL, int bid, int nb) {
    const int tid = threadIdx.x, lane = tid & 63, wave = tid >> 6, stride = nb * NWAVES;
    for (int ra = bid * NWAVES + wave; ra < MT; ra += 2 * stride) {
        const int rb = ra + stride; const bool hasb = rb < MT;
        float4 v[2][4];
#pragma unroll
        for (int q = 0; q < 2; ++q) { const int r = q ? (hasb ? rb : ra) : ra; const int b0 = r / TT, t0 = r - b0 * TT;
            const float4* xr = (const float4*)(t0 < CTX ? ctxin + ((size_t)b0 * CTX + t0) * D : xin + ((size_t)b0 * SEQ + (t0 - CTX)) * D) + lane;
#pragma unroll
            for (int j = 0; j < 4; ++j) v[q][j] = xr[64 * j]; }
#pragma unroll
        for (int q = 0; q < 2; ++q) {
            if (q == 1 && !hasb) break;
            const int r = q ? rb : ra;
            float ss = 0.f;
#pragma unroll
            for (int j = 0; j < 4; ++j) ss += v[q][j].x * v[q][j].x + v[q][j].y * v[q][j].y + v[q][j].z * v[q][j].z + v[q][j].w * v[q][j].w;
            ss = wave_sum(ss);
            const float rstd = 1.f / sqrtf(ss * (1.f / D) + EPS);
            const int mi = mod_index(r);
            const float* sh = MODL + mi * 6144; const float* sc = sh + 1024;
#pragma unroll
            for (int j = 0; j < 4; ++j) {
                const int c = (lane + 64 * j) * 4;
                const float4 g4 = *(const float4*)(g + c), s4 = *(const float4*)(sh + c), c4 = *(const float4*)(sc + c);
                u32x2_t w; w.x = pk_bf16(v[q][j].x * rstd * g4.x * (1.f + c4.x) + s4.x, v[q][j].y * rstd * g4.y * (1.f + c4.y) + s4.y);
                w.y = pk_bf16(v[q][j].z * rstd * g4.z * (1.f + c4.z) + s4.z, v[q][j].w * rstd * g4.w * (1.f + c4.w) + s4.w);
                *((u32x2_t*)(H + (size_t)r * D) + lane + 64 * j) = w;
            }
        }
    }
}
template <int N, int O>
__device__ __forceinline__ void rs_step(float* v, int lane) {
    const bool up = (lane & O) != 0;
#pragma unroll
    for (int i = 0; i < N / 2; ++i) { const float send = up ? v[i] : v[N / 2 + i], keep = up ? v[N / 2 + i] : v[i]; v[i] = keep + __shfl_xor(send, O); }
}
__device__ __forceinline__ void phase_norm2_router(LAS unsigned char* ldsb, bf16_t* X, unsigned char* H8p, const float* g, const float* MODL, const float* wr, float* AFF, int* SEL, int bid, int nb, bool latent_only, const bf16_t* CP, const float* ctxin) {
    const int tid = threadIdx.x, lane = tid & 63, wave = tid >> 6;
    LAS f32x4* W2 = (LAS f32x4*)ldsb;
    LAS float* lg = (LAS float*)(ldsb + 65536) + wave * 64;
    __syncthreads();
    for (int idx = tid; idx < 4096; idx += NT) { const int c = idx >> 2, e4 = idx & 3, ln = (c >> 2) & 63, j = c >> 8, q = c & 3;
        W2[((j * 4 + q) * 4 + e4) * 64 + ln] = *(const f32x4*)(wr + (size_t)c * 16 + e4 * 4); }
    __syncthreads();
    if (CP != nullptr) {
#pragma unroll 1
        for (int r0 = (bid * NWAVES + wave) * 3; r0 < MT; r0 += nb * NWAVES * 3) {
            if ((r0 % TT) >= CTX) continue;
#pragma unroll 1
            for (int rr = 0; rr < 3; ++rr) { const int r = r0 + rr, bq = r / TT, tq = r - bq * TT;
                if (tq >= CTX) continue;
                u32x2_t pw[4][4]; float4 in4[4];
#pragma unroll
                for (int s = 0; s < 4; ++s)
#pragma unroll
                    for (int j = 0; j < 4; ++j) pw[s][j] = *((const u32x2_t*)(CP + (((size_t)s * NB + bq) * 256 + tq) * D) + lane + 64 * j);
#pragma unroll
                for (int j = 0; j < 4; ++j) in4[j] = *((const float4*)(ctxin + ((size_t)bq * CTX + tq) * D) + lane + 64 * j);
#pragma unroll
                for (int j = 0; j < 4; ++j) { const float4 g4 = *((const float4*)(MODL + 8 * 6144 + 2 * 1024) + lane + 64 * j);
                    float4 a = make_float4(0.f, 0.f, 0.f, 0.f);
#pragma unroll
                    for (int s = 0; s < 4; ++s) { a.x += __builtin_bit_cast(float, pw[s][j].x << 16); a.y += __builtin_bit_cast(float, pw[s][j].x & 0xffff0000u); a.z += __builtin_bit_cast(float, pw[s][j].y << 16); a.w += __builtin_bit_cast(float, pw[s][j].y & 0xffff0000u); }
                    u32x2_t w; w.x = pk_bf16(in4[j].x + g4.x * a.x, in4[j].y + g4.y * a.y); w.y = pk_bf16(in4[j].z + g4.z * a.z, in4[j].w + g4.w * a.w);
                    *((u32x2_t*)(X + (size_t)r * D) + lane + 64 * j) = w; } }
        }
        asm volatile("s_waitcnt vmcnt(0)" ::: "memory");
    }
    for (int r0 = (bid * NWAVES + wave) * 3; r0 < MT; r0 += nb * NWAVES * 3) {
        if (latent_only && (r0 % TT) + 2 < CTX) continue;
        float hv[3][16];
#pragma unroll
        for (int rr = 0; rr < 3; ++rr) {
            const int r = r0 + rr;
            u32x2_t* xr = (u32x2_t*)(X + (size_t)r * D) + lane;
            float4 v[4]; float ss = 0.f;
            { u32x2_t xw[4];
#pragma unroll
              for (int j = 0; j < 4; ++j) xw[j] = xr[64 * j];
#pragma unroll
              for (int j = 0; j < 4; ++j) v[j] = make_float4(__builtin_bit_cast(float, xw[j].x << 16), __builtin_bit_cast(float, xw[j].x & 0xffff0000u), __builtin_bit_cast(float, xw[j].y << 16), __builtin_bit_cast(float, xw[j].y & 0xffff0000u)); }
#pragma unroll
            for (int j = 0; j < 4; ++j) ss += v[j].x * v[j].x + v[j].y * v[j].y + v[j].z * v[j].z + v[j].w * v[j].w;
            ss = wave_sum(ss);
            const float rstd = 1.f / sqrtf(ss * (1.f / D) + EPS);
            const int mi = mod_index(r);
            const float* sh = MODL + mi * 6144 + 3 * 1024; const float* sc = sh + 1024;
#pragma unroll
            for (int j = 0; j < 4; ++j) {
                const int c = (lane + 64 * j) * 4;
                const float4 g4 = *(const float4*)(g + c), s4 = *(const float4*)(sh + c), c4 = *(const float4*)(sc + c);
                hv[rr][4 * j + 0] = v[j].x * rstd * g4.x * (1.f + c4.x) + s4.x; hv[rr][4 * j + 1] = v[j].y * rstd * g4.y * (1.f + c4.y) + s4.y;
                hv[rr][4 * j + 2] = v[j].z * rstd * g4.z * (1.f + c4.z) + s4.z; hv[rr][4 * j + 3] = v[j].w * rstd * g4.w * (1.f + c4.w) + s4.w;
                *((unsigned*)(H8p + (size_t)r * D) + lane + 64 * j) = pk4_fp8(hv[rr][4 * j], hv[rr][4 * j + 1], hv[rr][4 * j + 2], hv[rr][4 * j + 3]);
            }
            asm volatile("" ::: "memory");
        }
        float p[48];
#pragma unroll
        for (int i = 0; i < 48; ++i) p[i] = 0.f;
#pragma unroll
        for (int jq = 0; jq < 16; ++jq)
#pragma unroll
            for (int e4 = 0; e4 < 4; ++e4) { const f32x4 w = W2[(jq * 4 + e4) * 64 + lane];
#pragma unroll
                for (int rr = 0; rr < 3; ++rr)
#pragma unroll
                    for (int t = 0; t < 4; ++t) p[rr * 16 + e4 * 4 + t] = fmaf(hv[rr][jq], w[t], p[rr * 16 + e4 * 4 + t]); }
        rs_step<48, 32>(p, lane); rs_step<24, 16>(p, lane); rs_step<12, 8>(p, lane); rs_step<6, 4>(p, lane);
#pragma unroll
        for (int i = 0; i < 3; ++i) { p[i] += __shfl_xor(p[i], 2); p[i] += __shfl_xor(p[i], 1); }
        const int base = ((lane & 32) ? 24 : 0) + ((lane & 16) ? 12 : 0) + ((lane & 8) ? 6 : 0) + ((lane & 4) ? 3 : 0);
        if ((lane & 3) == 0) { lg[base] = p[0]; lg[base + 1] = p[1]; lg[base + 2] = p[2]; }
        asm volatile("s_waitcnt lgkmcnt(0)" ::: "memory");
        float x = lane < 48 ? lg[lane] : 0.f;
        float mx = x;
        mx = fmaxf(mx, __shfl_xor(mx, 1)); mx = fmaxf(mx, __shfl_xor(mx, 2)); mx = fmaxf(mx, __shfl_xor(mx, 4)); mx = fmaxf(mx, __shfl_xor(mx, 8));
        const float ex = expf(x - mx);
        float den = ex;
        den += __shfl_xor(den, 1); den += __shfl_xor(den, 2); den += __shfl_xor(den, 4); den += __shfl_xor(den, 8);
        if (lane < 48) { const size_t o = (size_t)(r0 + (lane >> 4)) * 16 + (lane & 15); AFF[o] = ex / den; SEL[o] = -1; }
        asm volatile("s_waitcnt lgkmcnt(0)" ::: "memory");
    }
}

__device__ __forceinline__ int block_excl_scan(int v, int& total, volatile LAS int* wsum, int tid) {
    const int lane = tid & 63, wave = tid >> 6;
    int inc = v;
#pragma unroll
    for (int o = 1; o < 64; o <<= 1) { const int t = __shfl_up(inc, o); if (lane >= o) inc += t; }
    __syncthreads();
    if (lane == 63) wsum[wave] = inc;
    __syncthreads();
    int off = 0, tot = 0;
#pragma unroll
    for (int w = 0; w < NWAVES; ++w) { const int s = wsum[w]; tot += s; off += (w < wave) ? s : 0; }
    total = tot;
    return off + inc - v;
}
__device__ __forceinline__ void phase_topk(LAS unsigned char* ldsb, const float* AFF, int* SEL, int* AROW, float* GATE, bool with_ctx, int bid, int nb) {
    const int tid = threadIdx.x;
    volatile LAS int* hist = (volatile LAS int*)ldsb;
    volatile LAS int* wsum = hist + 256;
    volatile LAS unsigned* ctl = (volatile LAS unsigned*)(hist + 272);
    const int nunits = with_ctx ? 256 : 128;
    for (int u = bid; u < nunits; u += nb) {
        const int kind = u >> 7, b = (u >> 4) & 7, e = u & 15;
        const int n = kind ? CTX : SEQ, cap = kind ? 32 : 256, row0 = b * TT + (kind ? 0 : CTX);
        unsigned key[4];
#pragma unroll
        for (int j = 0; j < 4; ++j) { const int i = 4 * tid + j; key[j] = i < n ? __builtin_bit_cast(unsigned, AFF[(size_t)(row0 + i) * 16 + e]) : 0u; }
        unsigned prefix = 0u; int need = cap;
#pragma unroll 1
        for (int pass = 3; pass >= 0; --pass) {
            __syncthreads();
            if (tid < 256) hist[tid] = 0;
            __syncthreads();
            const int sh = 8 * pass;
#pragma unroll
            for (int j = 0; j < 4; ++j) { const bool match = (pass == 3) ? (key[j] != 0u) : ((key[j] >> (sh + 8)) == (prefix >> (sh + 8)) && key[j] != 0u);
                if (match) (void)__hip_atomic_fetch_add((LAS int*)&hist[(key[j] >> sh) & 255u], 1, __ATOMIC_RELAXED, __HIP_MEMORY_SCOPE_WORKGROUP); }
            __syncthreads();
            if (tid < 64) {
                const int h0 = hist[4 * tid], h1 = hist[4 * tid + 1], h2 = hist[4 * tid + 2], h3 = hist[4 * tid + 3];
                const int mine = h0 + h1 + h2 + h3;
                int inc = mine;
#pragma unroll
                for (int o = 1; o < 64; o <<= 1) { const int t = __shfl_down(inc, o); if (tid + o < 64) inc += t; }
                const int above = inc - mine;
                if (above < need && need <= inc) {
                    int dg, ab = above;
                    if (ab + h3 >= need) dg = 3; else { ab += h3; if (ab + h2 >= need) dg = 2; else { ab += h2; if (ab + h1 >= need) dg = 1; else { ab += h1; dg = 0; } } }
                    ctl[0] = prefix | ((unsigned)(4 * tid + dg) << sh); ctl[1] = (unsigned)(need - ab);
                }
            }
            __syncthreads();
            prefix = ctl[0]; need = (int)ctl[1];
        }
        int eqc = 0;
#pragma unroll
        for (int j = 0; j < 4; ++j) eqc += (key[j] == prefix) ? 1 : 0;
        int tot;
        int eqpos = block_excl_scan(eqc, tot, wsum, tid);
        int selc = 0; bool sel[4];
#pragma unroll
        for (int j = 0; j < 4; ++j) { const bool eq = key[j] == prefix; sel[j] = key[j] > prefix || (eq && eqpos < need); eqpos += eq ? 1 : 0; selc += sel[j] ? 1 : 0; }
        int slot = block_excl_scan(selc, tot, wsum, tid);
#pragma unroll
        for (int j = 0; j < 4; ++j) if (sel[j]) { const int i = 4 * tid + j, m = kind ? 2048 + b * 32 + slot : b * 256 + slot; ++slot;
            AROW[e * MEXP + m] = row0 + i; GATE[e * MEXP + m] = __builtin_bit_cast(float, key[j]); SEL[(size_t)(row0 + i) * 16 + e] = m; }
    }
}

__device__ __forceinline__ void phase_combine(bf16_t* X, const bf16_t* Y, const bf16_t* Y2p, const int* SEL, int mrows, const float* MODL, bool latent_only, const float* fng, float* out, bf16_t* Hn, const float* gn1, const float* MODN, int bid, int nb) {
    const int tid = threadIdx.x, lane = tid & 63, wave = tid >> 6;
    for (int r = bid * NWAVES + wave; r < MT; r += nb * NWAVES) {
        const int b = r / TT, tp = r - b * TT;
        if (latent_only && tp < CTX) continue;
        float4 acc[4];
#pragma unroll
        for (int j = 0; j < 4; ++j) acc[j] = make_float4(0.f, 0.f, 0.f, 0.f);
        int msel[16];
        { const int4* sp = (const int4*)(SEL + (size_t)r * 16);
#pragma unroll
          for (int q = 0; q < 4; ++q) { const int4 s4 = sp[q]; msel[4 * q] = __builtin_amdgcn_readfirstlane(s4.x); msel[4 * q + 1] = __builtin_amdgcn_readfirstlane(s4.y); msel[4 * q + 2] = __builtin_amdgcn_readfirstlane(s4.z); msel[4 * q + 3] = __builtin_amdgcn_readfirstlane(s4.w); } }
        u32x2_t yv[16][4];
#pragma unroll
        for (int e = 0; e < 16; ++e) {
#pragma unroll
            for (int j = 0; j < 4; ++j) yv[e][j] = (u32x2_t){0u, 0u};
            const int m = msel[e];
            if (m >= 0) {
                if (Y2p != nullptr && m >= 2048) {
                    float4 t4[4];
#pragma unroll
                    for (int j = 0; j < 4; ++j) t4[j] = make_float4(0.f, 0.f, 0.f, 0.f);
#pragma unroll
                    for (int s = 0; s < 4; ++s) { const u32x2_t* y = (const u32x2_t*)(Y2p + (((size_t)s * NE + e) * 256 + (m - 2048)) * D) + lane;
#pragma unroll
                        for (int j = 0; j < 4; ++j) { const u32x2_t w = y[64 * j];
                            t4[j].x += __builtin_bit_cast(float, w.x << 16); t4[j].y += __builtin_bit_cast(float, w.x & 0xffff0000u); t4[j].z += __builtin_bit_cast(float, w.y << 16); t4[j].w += __builtin_bit_cast(float, w.y & 0xffff0000u); } }
#pragma unroll
                    for (int j = 0; j < 4; ++j) { acc[j].x += t4[j].x; acc[j].y += t4[j].y; acc[j].z += t4[j].z; acc[j].w += t4[j].w; }
                } else {
                    const u32x2_t* y = (const u32x2_t*)(Y + ((size_t)e * mrows + m) * D) + lane;
#pragma unroll
                    for (int j = 0; j < 4; ++j) yv[e][j] = y[64 * j];
                }
            }
        }
#pragma unroll
        for (int e = 0; e < 16; ++e)
#pragma unroll
            for (int j = 0; j < 4; ++j) { const u32x2_t w = yv[e][j];
                acc[j].x += __builtin_bit_cast(float, w.x << 16); acc[j].y += __builtin_bit_cast(float, w.x & 0xffff0000u); acc[j].z += __builtin_bit_cast(float, w.y << 16); acc[j].w += __builtin_bit_cast(float, w.y & 0xffff0000u); }
        const float* gm = MODL + mod_index(r) * 6144 + 5 * 1024;
        u32x2_t* xr = (u32x2_t*)(X + (size_t)r * D) + lane;
        u32x2_t xw[4]; float4 xv[4]; float ss = 0.f;
#pragma unroll
        for (int j = 0; j < 4; ++j) xw[j] = xr[64 * j];
#pragma unroll
        for (int j = 0; j < 4; ++j) { const float4 g4 = *((const float4*)gm + lane + 64 * j);
            float4 x = make_float4(__builtin_bit_cast(float, xw[j].x << 16), __builtin_bit_cast(float, xw[j].x & 0xffff0000u), __builtin_bit_cast(float, xw[j].y << 16), __builtin_bit_cast(float, xw[j].y & 0xffff0000u));
            x.x += g4.x * acc[j].x; x.y += g4.y * acc[j].y; x.z += g4.z * acc[j].z; x.w += g4.w * acc[j].w; xv[j] = x;
            if (!out) { u32x2_t w; w.x = pk_bf16(x.x, x.y); w.y = pk_bf16(x.z, x.w); xr[64 * j] = w; }
            ss += x.x * x.x + x.y * x.y + x.z * x.z + x.w * x.w; }
        if (Hn) {
            ss = wave_sum(ss); const float rstd = 1.f / sqrtf(ss * (1.f / D) + EPS);
            const float* sh = MODN + mod_index(r) * 6144; const float* sc = sh + 1024;
#pragma unroll
            for (int j = 0; j < 4; ++j) { const int c = (lane + 64 * j) * 4;
                const float4 g4 = *(const float4*)(gn1 + c), s4 = *(const float4*)(sh + c), c4 = *(const float4*)(sc + c);
                u32x2_t w; w.x = pk_bf16(xv[j].x * rstd * g4.x * (1.f + c4.x) + s4.x, xv[j].y * rstd * g4.y * (1.f + c4.y) + s4.y);
                w.y = pk_bf16(xv[j].z * rstd * g4.z * (1.f + c4.z) + s4.z, xv[j].w * rstd * g4.w * (1.f + c4.w) + s4.w);
                *((u32x2_t*)(Hn + (size_t)r * D) + lane + 64 * j) = w; }
        }
        if (out) {
            ss = wave_sum(ss); const float rstd = 1.f / sqrtf(ss * (1.f / D) + EPS);
            float4* orow = (float4*)(out + ((size_t)b * SEQ + (tp - CTX)) * D) + lane;
#pragma unroll
            for (int j = 0; j < 4; ++j) { const float4 g4 = *((const float4*)fng + lane + 64 * j); float4 o; o.x = xv[j].x * rstd * g4.x; o.y = xv[j].y * rstd * g4.y; o.z = xv[j].z * rstd * g4.z; o.w = xv[j].w * rstd * g4.w; orow[64 * j] = o; }
        }
    }
}

__device__ __forceinline__ void phase_moe_up(LAS unsigned char* lds, const unsigned char* H8p, const int* AROWp, const unsigned char* WGU8p, unsigned char* HID8p, int mrows, int bid, int nb) {
    const int nMe = mrows / 256;
    pg8::Gemm g{(const bf16_t*)H8p, (const bf16_t*)WGU8p, NE * mrows, NE * 5632, D / 2};
    OrderShareB S{nMe, 22, NE * 22, nb, bid, AROWp};
    EpiSwiGLU E{HID8p, nMe};
    pg8::gemm_phase<EpiSwiGLU, OrderShareB, true, true, true, false, true>(lds, g, S, E);
}
__device__ __forceinline__ void phase_moe_down(LAS unsigned char* lds, const unsigned char* HID8p, const unsigned char* WDT8p, bf16_t* YFp, bf16_t* Y2p, const float* GATE, int mrows, int bid, int nb) {
    const int nMe = mrows / 256;
    pg8::Gemm g{(const bf16_t*)HID8p, (const bf16_t*)WDT8p, NE * mrows, NE * D, FF / 2};
    if (Y2p == nullptr) {
        OrderShareA S{nMe, 4, NE * nMe, nb, bid, nMe};
        EpiDownGate E{YFp, GATE, nMe};
        pg8::gemm_phase<EpiDownGate, OrderShareA, true, true, false, false, true>(lds, g, S, E);
    } else {
        { OrderShareA S{nMe, 4, NE * 8, nb, bid, 8}; EpiDownGate E{YFp, GATE, nMe};
          pg8::gemm_phase<EpiDownGate, OrderShareA, true, true, false, false, true>(lds, g, S, E); }
        { OrderCtxSplitK S{nb, bid}; EpiDownCtxPart E{Y2p, GATE};
          pg8::gemm_phase<EpiDownCtxPart, OrderCtxSplitK, true, true, false, true, true>(lds, g, S, E); }
    }
}
#define SSQ ((float*)(ws + WS_PSSQ))
#define MOD ((float*)(ws + WS_MOD))
#define LB1 ((float*)(ws + WS_LB1))
#define RDA ((float2*)(ws + WS_RDA))
#define RR ((float2*)(ws + WS_RR))
#define X ((bf16_t*)(ws + WS_X))
#define H ((bf16_t*)(ws + WS_H))
#define AFF ((float*)(ws + WS_AFF))
#define SEL ((int*)(ws + WS_SEL))
#define AROW ((int*)(ws + WS_AROW))
#define GATE ((float*)(ws + WS_GATE))
#define QK ((bf16_t*)(ws + WS_QK))
#define V1 ((bf16_t*)(ws + WS_V1))
#define CQ ((bf16_t*)(ws + WS_CQ))
#define CKV ((bf16_t*)(ws + WS_CKV))
#define KR ((bf16_t*)(ws + WS_KR))
#define QM ((bf16_t*)(ws + WS_QM))
#define KVM ((bf16_t*)(ws + WS_KVM))
#define ODA ((float*)(ws + WS_ODA))
#define AO ((bf16_t*)(ws + WS_AO))
#define HIDB ((unsigned char*)(ws + WS_HIDB))
#define H8 ((unsigned char*)(ws + WS_H8))
#define WGU8 ((unsigned char*)(ws + WS_WGU))
#define WDT8 ((unsigned char*)(ws + WS_WD))
#define YF ((bf16_t*)(ws + WS_YF))
#define Y2 ((bf16_t*)(ws + WS_Y2))
#define CPART ((bf16_t*)(ws + WS_HIDB))
#define RB ((bf16_t*)(ws + WS_RB))
#define LF ((bf16_t*)(ws + WS_LF))
#define LAD ((bf16_t*)(ws + WS_LF + 36 * MiB))
#define GD ((float*)(ws + WS_GD))
#define KVT0 ((unsigned*)(ws + WS_KVT0))
#define KVT1 ((unsigned*)(ws + WS_KVT1))
#define SST0 ((bf16_t*)(ws + WS_SST0))
#define SST1 ((bf16_t*)(ws + WS_SST1))
#define DEC ((float*)(ws + WS_DEC))
#define R ((bf16_t*)(ws + WS_R))
#define WIN ((bf16_t*)(ws + WS_WIN))
#define WQ ((bf16_t*)(ws + WS_WQ))
#define WKV ((bf16_t*)(ws + WS_WKV))
#define WO ((bf16_t*)(ws + WS_WO))
#define WRI ((bf16_t*)(ws + WS_WRI))
#define WRO ((bf16_t*)(ws + WS_WRO))
#define WGU ((bf16_t*)(ws + WS_WGU))
#define WDT ((bf16_t*)(ws + WS_WD))
#define MOD1 (MOD + 9 * 6144)
__global__ void __launch_bounds__(NT, 2) fwd(Args args) {
    extern __shared__ __attribute__((aligned(16))) unsigned char lds_raw[];
    float* lds = (float*)lds_raw;
    LAS unsigned char* ldsl = (LAS unsigned char*)lds_raw;
    const int tid = threadIdx.x, lane = tid & 63, wave = __builtin_amdgcn_readfirstlane(tid >> 6), bid = blockIdx.x, nb = gridDim.x;
    unsigned char* ws = args.ws;
    volatile LAS unsigned* MISC = (volatile LAS unsigned*)(ldsl + MISC_OFF);
    if (tid < 32) MISC[tid] = 0u;
    __syncthreads();
    XcdBarrier bar; bar.bar = (unsigned*)(ws + WS_CTL) + CW_BAR; bar.x = 0; bar.st = nullptr;
#if MK_ONE_LAUNCH
    bar = xcd_barrier_post((unsigned*)(ws + WS_CTL) + CW_BAR, MISC + 8);
#endif
    const int lo = args.ph_lo, hi = args.ph_hi;
#ifdef ONLY_PHASE
#define IN(k) ((k) == ONLY_PHASE && lo <= (k) && (k) < hi)
#else
#define IN(k) (lo <= (k) && (k) < hi)
#endif
#if MK_ONE_LAUNCH
#define SEAM(k) do { if (IN(k) && IN((k) + 1)) xcd_barrier(bar); } while (0)
#define SEAM12() do { if (IN(12) && IN(14)) xcd_barrier(bar); } while (0)
#define SEAM2(a, b) do { if (IN(a) && IN(b)) xcd_barrier(bar); } while (0)
#else
#define SEAM(k) do { } while (0)
#define SEAM12() do { } while (0)
#define SEAM2(a, b) do { } while (0)
#endif

    if (IN(0)) {
        const size_t gtid = (size_t)bid * NT + tid, gthreads = (size_t)nb * NT;
        for (size_t i = gtid; i < (size_t)TT * 32; i += gthreads) { const int tp = (int)(i >> 5), j = (int)(i & 31); float2 cs = make_float2(1.f, 0.f);
            if (tp >= CTX) { const int t = tp - CTX; const float ang = (float)(j < 16 ? (t >> 6) : (t & 63)) * powf(10000.f, -(float)(j & 15) * (1.f / 16.f)); cs = make_float2(cosf(ang), sinf(ang)); }
            RDA[i] = cs; }
        for (size_t i = gtid; i < (size_t)TT * 16; i += gthreads) { const int tp = (int)(i >> 4), j = (int)(i & 15); float2 cs = make_float2(1.f, 0.f);
            if (tp >= CTX) { const int t = tp - CTX; const float ang = (float)(j < 8 ? (t >> 6) : (t & 63)) * powf(10000.f, -(float)(j & 7) * (1.f / 8.f)); cs = make_float2(cosf(ang), sinf(ang)); }
            RR[i] = cs; }
        { const float* lbl = args.in[I_LBL];
          for (size_t i = gtid; i < 1024; i += gthreads) { const float l0 = lbl[i], l1 = lbl[1024 + i], mx = fmaxf(l0, l1), e0 = expf(l0 - mx), e1 = expf(l1 - mx); LB1[i] = e1 / (e0 + e1); } }
        const float* c = args.in[I_C]; const float* cc = args.in[I_CCTX]; const float* adaw = args.in[I_ADAW]; const float* adab = args.in[I_ADAB];
        float* sc = lds; float* red = lds + 9 * 1024;
        for (int u = bid; u < 192; u += nb) {
            const int layer = u / 96, cb = u - layer * 96;
            __syncthreads();
            for (int i = tid; i < 9 * 1024; i += NT) { const int r = i >> 10, k = i & 1023; sc[i] = siluf(r < 8 ? c[r * 1024 + k] : cc[k]); }
            __syncthreads();
            const int kg = tid >> 6, col = cb * 64 + lane;
            float acc[9];
#pragma unroll
            for (int r = 0; r < 9; ++r) acc[r] = 0.f;
            for (int k = kg * 128; k < kg * 128 + 128; ++k) { const float w = adaw[((size_t)layer * 1024 + k) * 6144 + col];
#pragma unroll
                for (int r = 0; r < 9; ++r) acc[r] = fmaf(sc[r * 1024 + k], w, acc[r]); }
#pragma unroll
            for (int r = 0; r < 9; ++r) red[(kg * 9 + r) * 64 + lane] = acc[r];
            __syncthreads();
            for (int i = tid; i < 9 * 64; i += NT) { const int r = i >> 6, l = i & 63; float s = 0.f;
#pragma unroll
                for (int q = 0; q < 8; ++q) s += red[(q * 9 + r) * 64 + l];
                MOD[(layer * 9 + r) * 6144 + cb * 64 + l] = s + adab[layer * 6144 + cb * 64 + l]; }
        }
        __syncthreads();
        {
            LAS unsigned char* scr = ldsl + wave * 10240;
            const int gw = bid * NWAVES + wave, ngw = nb * NWAVES;
            constexpr int N_IN = 16 * 35, N_Q = 6 * 12, N_KV = 4 * 16, N_O = 16 * 16, N_RI = 16 * 65, N_RO = 16 * 16, N_TOT = N_IN + N_Q + N_KV + N_O + N_RI + N_RO;
            int it0 = gw, istep = ngw, ilim = N_TOT;
            if (nb == 256) { if (bid >= 192) { it0 = (bid - 192) * NWAVES + wave; istep = 512; ilim = 1536; } else { it0 = 1536 + gw; istep = 1 << 20; } }
            for (int it = it0; it < ilim; it += istep) {
                int r = it;
                if (r < N_IN) { conv_item(args.in[I_ATTWIN], ATT_IN, ATT_IN, D, (r / 35) * 64, (r % 35) * 64, WIN, MapAttIn{}, nullptr, scr, lane); continue; }
                r -= N_IN;
                if (r < N_Q) { conv_item(args.in[I_QUP], 768, 768, 384, (r / 12) * 64, (r % 12) * 64, WQ, MapQUp{}, args.in[I_QNG], scr, lane); continue; }
                r -= N_Q;
                if (r < N_KV) { conv_item(args.in[I_KVUP], 1024, 1024, 256, (r / 16) * 64, (r % 16) * 64, WKV, MapKVUp{}, args.in[I_KVNG], scr, lane); continue; }
                r -= N_KV;
                if (r < N_O) { conv_item(args.in[I_ATTWOUT], D, D, D, (r / 16) * 64, (r % 16) * 64, WO, MapIdent{}, nullptr, scr, lane); continue; }
                r -= N_O;
                if (r < N_RI) { conv_item(args.in[I_RECWIN], REC_IN, REC_IN, D, (r / 65) * 64, (r % 65) * 64, WRI, MapRecIn{}, nullptr, scr, lane); continue; }
                r -= N_RI;
                conv_item(args.in[I_RECWOUT], D, D, D, (r / 16) * 64, (r % 16) * 64, WRO, MapIdent{}, nullptr, scr, lane);
            }
        }
    }
    SEAM(0);
    if (IN(1)) phase_norm1(args.in[I_X], args.in[I_CTX], H, args.in[I_N1G], MOD, bid, nb);
    SEAM(1);
    if (IN(2)) {
        pg8::Gemm g{H, WIN, MT, 2304, D}; pg8::StaticOrder S; S.init(MT, 2304, nb, bid);
        EpiAttnIn E{QK, V1, CQ, CKV, KR, SSQ, RDA, RR};
        pg8::gemm_phase<EpiAttnIn, pg8::StaticOrder, true, true>(ldsl, g, S, E);
        if (nb == 256 && bid >= 136) { const ConvCtx c0{args.in[I_WG], args.in[I_WU], args.in[I_WD], WGU8, WDT8, 0, 0, 0};
            conv_tail(c0, ldsl, N_ATTITEMS, 4, (bid - 136) * NWAVES + wave, 120 * NWAVES, N_ATTITEMS + N_TAIL2); }
    }
    SEAM(2);
    if (IN(3)) {
        { pg8::Gemm g{CQ, WQ, MT, 768, 384}; pg8::StaticOrder S; S.init(MT, 768, nb, bid); EpiMlaQ E{QM, SSQ, RR};
          pg8::gemm_phase<EpiMlaQ, pg8::StaticOrder, true, true>(ldsl, g, S, E); }
        { pg8::Gemm g{CKV, WKV, MT, 1024, 256}; pg8::StaticOrder S; S.init(MT, 1024, nb, (bid + 40) % nb); EpiMlaKV E{KVM, SSQ};
          pg8::gemm_phase<EpiMlaKV, pg8::StaticOrder, true, true>(ldsl, g, S, E); }
    }
    SEAM(3);
    if (IN(4)) {
        const float* lq1 = args.in[I_LQ1]; const float* lk1 = args.in[I_LK1]; const float* lq2 = args.in[I_LQ2]; const float* lk2 = args.in[I_LK2];
        float d1 = 0.f, d2 = 0.f;
        for (int i = 0; i < 64; ++i) { d1 = fmaf(lq1[i], lk1[i], d1); d2 = fmaf(lq2[i], lk2[i], d2); }
        const float lam_init = 0.2f, lam = expf(d1) - expf(d2) + lam_init;
        ConvCtx cc{args.in[I_WG], args.in[I_WU], args.in[I_WD], WGU8, WDT8, 0, nb * NWAVES, bid * NWAVES + __builtin_amdgcn_readfirstlane(threadIdx.x >> 6)};
        const int nslots = bid < 864 ? (864 - bid + nb - 1) / nb : 0; const bool mla_first = nb == 256 && ((bid >> 3) & 1);
        for (int js = 0; js < nslots; ++js) {
            const int u = bid + nb * ((mla_first && js < 3) ? (js + 1) % 3 : js);
            int kind, b, hm, qb;
            if (u < 256) { const int x = u & 7, j = u >> 3, pair = (j >> 3) * 8 + x; kind = 0; qb = 1 + (j & 7); b = pair >> 2; hm = pair & 3; }
            else if (u < 768) { const int uu = u - 256, x = uu & 7, j = uu >> 3, pair = (j >> 3) * 8 + x; kind = 1; qb = 1 + (j & 7); b = pair >> 3; hm = pair & 7; }
            else { const int uu = u - 768; qb = 0; if (uu < 32) { kind = 0; b = uu >> 2; hm = uu & 3; } else { kind = 1; b = (uu - 32) >> 3; hm = (uu - 32) & 7; } }
            const int qrow0 = b * TT + qb * 256, krow0 = b * TT, nk = qb == 0 ? CTX : TT;
            if (kind == 0) { const int h = hm;
                attn_unit_mfma<64, 128, 1>(ldsl, QK + h * 128, nullptr, 1024, QK + 512 + h * 128, 1024, nullptr, 0, V1 + h * 128, 512, qrow0, krow0, nk, nullptr, 0, 0.f, nullptr, 0.f);
                attn_unit_mfma<64, 128, 2>(ldsl, QK + h * 128 + 64, nullptr, 1024, QK + 512 + h * 128 + 64, 1024, nullptr, 0, V1 + h * 128, 512, qrow0, krow0, nk, AO + h * 128, 1024, lam, args.in[I_SUBLN], 1.f - lam_init); }
            else { const int h = hm;
                attn_unit_mfma<96, 64, 0, true>(ldsl, QM + h * 64, QM + 512 + h * 32, 768, KVM + h * 64, 1024, KR, 32, KVM + 512 + h * 64, 1024, qrow0, krow0, nk, AO + 512 + h * 64, 1024, 0.f, nullptr, 0.f, &cc); }
        }
        {
            LAS unsigned char* scr = ldsl + 61440 + cc.offset % NWAVES * 10240; const int lane = threadIdx.x & 63;
            for (;; ++cc.n) { const int item = conv_item_index(cc, cc.n); if (item >= conv_att_limit(cc)) break;
                const ConvItem it = conv_decode_l1(cc, item); float4 cv[8];
#pragma unroll 1
                for (int q = 0; q < 2; ++q) { conv_q_issue(it, q, cv, lane); conv_q_stash(q, cv, scr, lane); }
                conv_finish(it, scr, lane); }
        }
    }
    SEAM2(4, 6);
    if (IN(6)) {
        { pg8::Gemm g{AO, WO, MT, D, D}; LatentOrder S; S.init(64 * 256, D, nb, bid); EpiResid2<true> E{X, MOD, args.in[I_X], args.in[I_CTX]};
          pg8::gemm_phase<EpiResid2<true>, LatentOrder, true, true>(ldsl, g, S, E); }
        { pg8::Gemm g{AO, WO, MT, D, D}; OrderCtxSplitK4 S{nb, bid}; EpiCtxPart E{CPART};
          pg8::gemm_phase<EpiCtxPart, OrderCtxSplitK4, true, true, false, true>(ldsl, g, S, E); }
    }
    SEAM(6);
    if (IN(7)) phase_norm2_router(ldsl, X, H8, args.in[I_N2G], MOD, args.in[I_ROUTER], AFF, SEL, bid, nb, false, CPART, args.in[I_CTX]);
    SEAM(7);
    if (IN(8)) phase_topk(ldsl, AFF, SEL, AROW, GATE, true, bid, nb);
    SEAM2(8, 10);
    if (IN(10)) { phase_moe_up(ldsl, H8, AROW, WGU8, HIDB, MEXP, bid, nb);
        if (nb == 256 && bid >= 96) { const ConvCtx c0{args.in[I_WG], args.in[I_WU], args.in[I_WD], WGU8, WDT8, 0, 0, 0};
            conv_tail(c0, ldsl, N_ATTITEMS + N_TAIL2, 2, (bid - 96) * NWAVES + wave, 160 * NWAVES, N_ATTITEMS + N_TAIL2 + N_TAIL10); } }
    SEAM(10);
    if (IN(11)) { phase_moe_down(ldsl, HIDB, WDT8, YF, Y2, GATE, MEXP, bid, nb); }
    SEAM(11);
    if (IN(12)) phase_combine(X, YF, Y2, SEL, MEXP, MOD, false, nullptr, nullptr, H, args.in[I_N1G] + D, MOD1, bid, nb);
    SEAM12();
    if (IN(14)) {
        pg8::Gemm g{H, WRI, MT, 4352, D}; pg8::StaticOrder S; S.init(MT, 4352, nb, bid); EpiRecIn E{RB, LF, GD, LB1};
        pg8::gemm_phase<EpiRecIn, pg8::StaticOrder, true, true>(ldsl, g, S, E);
        if (nb == 256 && bid >= 200) { const ConvCtx c0{args.in[I_WG], args.in[I_WU], args.in[I_WD], WGU8, WDT8, 0, 0, 0};
            conv_tail(c0, ldsl, N_ATTITEMS + N_TAIL2 + N_TAIL10, 4, (bid - 200) * NWAVES + wave, 56 * NWAVES, N_L1ITEMS); }
    }
    SEAM(14);
    if (IN(15)) {
        for (int u = bid; u < 2304; u += nb) { const int kind = u < 1152 ? 1 : 0, uu = u % 1152, c = uu % 36, ck = uu / 36, b = ck >> 2, h = ck & 3;
            if (kind) scan_s1_unit<1>(ldsl, b, h, c, RB, LF, GD, args.in[I_GKUP], args.in[I_GKB], KVT1, DEC, LAD);
            else scan_s1_unit<0>(ldsl, b, h, c, RB, LF, GD, args.in[I_GKUP], args.in[I_GKB], KVT0, DEC, LAD); }
    }
    SEAM(15);
    if (IN(16)) scan_s2(KVT0, KVT1, DEC, SST0, SST1, bid, nb);
    SEAM(16);
    if (IN(17)) {
        for (int u = bid; u < 2048; u += nb) { const int kind = u < 1024 ? 1 : 0, uu = u & 1023, lc = uu & 31, ck = uu >> 5, b = ck >> 2, h = ck & 3;
            if (kind) scan_s3_unit<1>(ldsl, b, h, lc, RB, LF, GD, args.in[I_GKUP], args.in[I_GKB], SST1, args.in[I_HGNG], R, LAD);
            else scan_s3_unit<0>(ldsl, b, h, lc, RB, LF, GD, args.in[I_GKUP], args.in[I_GKB], SST0, args.in[I_GLANG], R, LAD); }
    }
    SEAM(17);
    if (IN(18)) {
        pg8::Gemm g{R, WRO, MT, D, D}; LatentOrder S; S.init(64 * 256, D, nb, bid); EpiResid2<false> E{X, MOD1, nullptr, nullptr};
        pg8::gemm_phase<EpiResid2<false>, LatentOrder, true, true>(ldsl, g, S, E);
    }
    SEAM(18);
    if (IN(19)) phase_norm2_router(ldsl, X, H8, args.in[I_N2G] + D, MOD1, args.in[I_ROUTER] + D * NE, AFF, SEL, bid, nb, true, nullptr, nullptr);
    SEAM(19);
    if (IN(20)) phase_topk(ldsl, AFF, SEL, AROW, GATE, false, bid, nb);
    SEAM2(20, 22);
    if (IN(22)) phase_moe_up(ldsl, H8, AROW, WGU8 + (size_t)NE * 5632 * D, HIDB, 2048, bid, nb);
    SEAM(22);
    if (IN(23)) phase_moe_down(ldsl, HIDB, WDT8 + (size_t)NE * D * FF, YF, nullptr, GATE, 2048, bid, nb);
    SEAM(23);
    if (IN(24)) phase_combine(X, YF, nullptr, SEL, 2048, MOD1, true, args.in[I_FNG], args.out, nullptr, nullptr, nullptr, bid, nb);
#undef IN
#undef SEAM
}

extern "C" void kernel_launch(void* const* d_in, const int* in_sizes, int n_in, void* d_out, int out_size, void* d_ws, size_t ws_size, hipStream_t stream) {
    static int grid = 0;
    if (grid == 0) {
        if (n_in != 31 || out_size != NB * SEQ * D || ws_size < WS_END) { fprintf(stderr, "kernel_launch: unexpected problem (n_in %d out %d ws %zu need %zu)\n", n_in, out_size, ws_size, (size_t)WS_END); grid = -1; return; }
        int dev = 0, cus = 0, per_cu = 0;
        if (hipGetDevice(&dev) != hipSuccess || hipDeviceGetAttribute(&cus, hipDeviceAttributeMultiprocessorCount, dev) != hipSuccess) { grid = -1; return; }
        if (hipFuncSetAttribute((const void*)fwd, hipFuncAttributeMaxDynamicSharedMemorySize, LDS_BYTES) != hipSuccess) { fprintf(stderr, "kernel_launch: hipFuncSetAttribute failed\n"); grid = -1; return; }
        if (hipOccupancyMaxActiveBlocksPerMultiprocessor(&per_cu, (const void*)fwd, NT, LDS_BYTES) != hipSuccess || per_cu < 1) { fprintf(stderr, "kernel_launch: occupancy query says %d\n", per_cu); }
        (void)hipGetLastError();
        grid = cus;
    }
    if (grid < 0) return;
    (void)hipMemsetAsync((char*)d_ws + WS_CTL, 0, CTL_ZERO_BYTES, stream);
    Args a{};
    for (int i = 0; i < 31; ++i) a.in[i] = (const float*)d_in[i];
    a.out = (float*)d_out; a.ws = (unsigned char*)d_ws;
#if MK_ONE_LAUNCH
    a.ph_lo = 0; a.ph_hi = N_PHASES;
    hipLaunchKernelGGL(fwd, dim3(grid), dim3(NT), LDS_BYTES, stream, a);
#else
    for (int p = 0; p < N_PHASES - 1; ++p) {
        int reps = 1;
        if (PROBE_REP == 1 && p == 0) reps = 2;
        if (PROBE_REP == 2 && p == 4) reps = 2;
        if (PROBE_REP == 3 && (p == 10 || p == 11 || p == 22 || p == 23)) reps = 2;
        if (PROBE_REP == 4 && (p == 15 || p == 16 || p == 17)) reps = 2;
        if (PROBE_REP == 5 && (p == 3 || p == 14)) reps = 2;
        if (PROBE_REP == 6 && (p == 1 || p == 5 || p == 7 || p == 8 || p == 9 || p == 13 || p == 19 || p == 20 || p == 21)) reps = 2;
        if (PROBE_REP == 7 && p == 15) reps = 2;
        if (PROBE_REP == 8 && p == 16) reps = 2;
        if (PROBE_REP == 9 && p == 17) reps = 2;
        if (PROBE_REP == 10 && p == 3) reps = 2;
        if (PROBE_REP == 11 && (p == 10 || p == 22)) reps = 2;
        if (PROBE_REP == 12 && (p == 11 || p == 23)) reps = 2;
        if (PROBE_REP == 13 && p == 2) reps = 2;
        if (PROBE_REP == 14 && p == 14) reps = 2;
        if (PROBE_REP == 15 && p == 1) reps = 2;
        if (PROBE_REP == 16 && (p == 7 || p == 19)) reps = 2;
        if (PROBE_REP == 17 && (p == 8 || p == 20)) reps = 2;
        if (PROBE_REP == 18 && p == 5) reps = 2;
        for (int r = 0; r < reps; ++r) { a.ph_lo = p; a.ph_hi = p + 1; hipLaunchKernelGGL(fwd, dim3(grid), dim3(NT), LDS_BYTES, stream, a); }
    }
#endif
}
```

```cpp
#include <hip/hip_runtime.h>
#include <cstdio>
#include <cstdint>

#ifndef MK_ONE_LAUNCH
#define MK_ONE_LAUNCH 1
#endif
#ifndef PROBE_REP
#define PROBE_REP 0
#endif

constexpr int NB = 8, SEQ = 2048, CTX = 256, TT = CTX + SEQ, D = 1024, MT = NB * TT;
constexpr int ATT_IN = 2208, REC_IN = 4128, NE = 16, FF = 2816, MEXP = 2304;
constexpr float EPS = 1e-6f;
constexpr int NT = 512, NWAVES = 8;
constexpr float LOG2E = 1.4426950408889634f;
constexpr float QS_DA = 0.125f * LOG2E, QS_MLA = 0.10206207261596577f * LOG2E;

constexpr size_t MiB = 1u << 20;
constexpr size_t WS_CTL = 0, CTL_ZERO_BYTES = 1 * MiB;
constexpr size_t WS_MOD = 1 * MiB;
constexpr size_t WS_LB1 = WS_MOD + 512 * 1024;
constexpr size_t WS_RDA = 2 * MiB;
constexpr size_t WS_RR = 3 * MiB;
constexpr size_t WS_X = 4 * MiB;
constexpr size_t WS_H = 76 * MiB;
constexpr size_t WS_AFF = 112 * MiB;
constexpr size_t WS_SEL = 114 * MiB;
constexpr size_t WS_AROW = 116 * MiB;
constexpr size_t WS_GATE = 117 * MiB;
constexpr size_t WS_BIG = 118 * MiB;
constexpr size_t WS_QK = WS_BIG;
constexpr size_t WS_V1 = WS_BIG + 36 * MiB;
constexpr size_t WS_CQ = WS_BIG + 54 * MiB;
constexpr size_t WS_CKV = WS_BIG + 68 * MiB;
constexpr size_t WS_KR = WS_BIG + 77 * MiB;
constexpr size_t WS_QM = WS_BIG + 79 * MiB;
constexpr size_t WS_KVM = WS_BIG + 106 * MiB;
constexpr size_t WS_ODA = WS_BIG + 142 * MiB;
constexpr size_t WS_AO = WS_BIG + 214 * MiB;
constexpr size_t WS_H8 = WS_BIG;
constexpr size_t WS_HIDB = WS_BIG + 72 * MiB;
constexpr size_t WS_YF = WS_BIG + 270 * MiB;
constexpr size_t WS_Y2 = WS_BIG + 342 * MiB;
constexpr size_t WS_RB = WS_BIG;
constexpr size_t WS_LF = WS_BIG + 108 * MiB;
constexpr size_t WS_GD = WS_BIG + 180 * MiB;
constexpr size_t WS_KVT0 = WS_BIG + 183 * MiB;
constexpr size_t WS_KVT1 = WS_BIG + 255 * MiB;
constexpr size_t WS_SST0 = WS_BIG + 399 * MiB;
constexpr size_t WS_SST1 = WS_BIG + 431 * MiB;
constexpr size_t WS_DEC = WS_BIG + 495 * MiB;
constexpr size_t WS_R = WS_BIG + 498 * MiB;
constexpr size_t WS_WIN = WS_BIG + 534 * MiB;
constexpr size_t WS_WQ = WS_WIN + 5 * MiB;
constexpr size_t WS_WKV = WS_WQ + 1 * MiB;
constexpr size_t WS_WO = WS_WKV + 1 * MiB;
constexpr size_t WS_WRI = WS_WO + 2 * MiB;
constexpr size_t WS_WRO = WS_WRI + 9 * MiB;
constexpr size_t WS_WGU = WS_WRO + 2 * MiB;
constexpr size_t WS_WD = WS_WGU + 2 * 176 * MiB;
constexpr size_t WS_PSSQ = WS_WD + 2 * 88 * MiB;
constexpr size_t WS_END = WS_PSSQ + 2 * MiB;

constexpr int CW_BAR = 4096;
constexpr int LDS_BYTES = 147456;
constexpr int MISC_OFF = LDS_BYTES - 128;

#define LAS __attribute__((address_space(3)))

#define XB_TMO      128
#define XB_XCNT(j)  (256  + 64 * (j))
#define XB_XSUB(j)  (1280 + 64 * (j))
#define XB_XGEN(j)  (2304 + 64 * (j))
#define XB_TOP      3328
#define XB_TOPGEN   3392
#define XCD_BAR_WORDS 3456
#define XB_SPIN_CAP (1u << 25)

__device__ __forceinline__ unsigned xb_ld(unsigned* p)              { return __hip_atomic_load(p, __ATOMIC_RELAXED, __HIP_MEMORY_SCOPE_AGENT); }
__device__ __forceinline__ unsigned xb_add(unsigned* p, unsigned v) { return __hip_atomic_fetch_add(p, v, __ATOMIC_RELAXED, __HIP_MEMORY_SCOPE_AGENT); }
__device__ __forceinline__ unsigned xb_xcc_id() { return (unsigned)__builtin_amdgcn_s_getreg((3 << 11) | 20) & 0xFu; }
#define XB_SPIN(cond, bar) do { unsigned _sp = 0; while (cond) { __builtin_amdgcn_s_sleep(1); \
    if ((++_sp & 255u) == 0u) { if (xb_ld(&(bar)[XB_TMO])) break; if (_sp > XB_SPIN_CAP) { atomicAdd(&(bar)[XB_TMO], 1u); break; } } } } while (0)

struct XcdBarrier { unsigned* bar; unsigned x; volatile LAS unsigned* st; };

__device__ __forceinline__ XcdBarrier xcd_barrier_post(unsigned* bar, volatile LAS unsigned* st) {
    XcdBarrier b; b.bar = bar; b.x = xb_xcc_id(); b.st = st;
    if (threadIdx.x == 0) (void)xb_add(&bar[XB_XCNT(b.x)], 1u);
    return b;
}
__device__ __forceinline__ void xcd_barrier_complete(unsigned* bar, unsigned x, unsigned& nloc, unsigned& nx) {
    const unsigned G = gridDim.x * gridDim.y * gridDim.z;
    unsigned sum, cnt, mine, sp = 0u;
    for (;;) {
        sum = 0u; cnt = 0u; mine = 0u;
#pragma unroll
        for (unsigned j = 0; j < 16; ++j) { const unsigned c = xb_ld(&bar[XB_XCNT(j)]); sum += c; cnt += (c > 0u) ? 1u : 0u; mine = (j == x) ? c : mine; }
        if (sum == G) break;
        __builtin_amdgcn_s_sleep(1);
        if ((++sp & 255u) == 0u) { if (xb_ld(&bar[XB_TMO])) break; if (sp > XB_SPIN_CAP) { atomicAdd(&bar[XB_TMO], 1u); break; } }
    }
    nloc = mine > 0u ? mine : 1u; nx = cnt > 0u ? cnt : 1u;
}
__device__ __forceinline__ void xcd_barrier(const XcdBarrier& b) {
    asm volatile("s_waitcnt vmcnt(0)" ::: "memory");
    __syncthreads();
    if (threadIdx.x == 0) {
        unsigned* bar = b.bar;
        __builtin_amdgcn_s_waitcnt(0);
        unsigned nloc = b.st[0], nx = b.st[1];
        if (nloc == 0u) { xcd_barrier_complete(bar, b.x, nloc, nx); b.st[0] = nloc; b.st[1] = nx; }
        const unsigned old = xb_add(&bar[XB_XSUB(b.x)], 1u);
        const unsigned gen = old / nloc;
        if (old + 1u == (gen + 1u) * nloc) {
            __builtin_amdgcn_fence(__ATOMIC_RELEASE, "agent");
            asm volatile("s_waitcnt vmcnt(0)" ::: "memory");
            const unsigned og = xb_add(&bar[XB_TOP], 1u);
            const unsigned tg = og / nx;
            if (og + 1u == (tg + 1u) * nx) xb_add(&bar[XB_TOPGEN], 1u);
            else XB_SPIN(xb_ld(&bar[XB_TOPGEN]) == tg, bar);
            __builtin_amdgcn_fence(__ATOMIC_ACQUIRE, "agent");
            xb_add(&bar[XB_XGEN(b.x)], 1u);
            asm volatile("s_waitcnt vmcnt(0)" ::: "memory");
        } else {
            XB_SPIN(xb_ld(&bar[XB_XGEN(b.x)]) == gen, bar);
            __builtin_amdgcn_fence(__ATOMIC_ACQUIRE, "agent");
            asm volatile("s_waitcnt vmcnt(0)" ::: "memory");
        }
    }
    __syncthreads();
}

namespace pg8 {
#define PG8_LAS __attribute__((address_space(3)))
typedef unsigned short bf16_t;
typedef short bf16x8 __attribute__((ext_vector_type(8)));
typedef float f32x4 __attribute__((ext_vector_type(4)));
typedef unsigned u32x4 __attribute__((ext_vector_type(4)));
typedef int v8i32 __attribute__((ext_vector_type(8)));
constexpr int BM = 256, BK = 64, HALF = 128, HTB = HALF * BK * 2  , STAGE_BYTES = 8 * HTB, NXCD = 8, WGM = 8;

__host__ __device__ __forceinline__ int lds_byte(int r, int c) { const int st = (r >> 4) * 2 + (c >> 5), rr = r & 15, cc = c & 31, ob = rr * 64 + cc * 2; return st * 1024 + (ob ^ (((ob >> 9) & 1) << 5)); }
__host__ __device__ __forceinline__ void stage_rc(int b, int& R, int& C) { const int st = b / 1024, sb = b % 1024, swz = sb ^ (((sb >> 9) & 1) << 5); R = (st >> 1) * 16 + swz / 64; C = (st & 1) * 32 + (swz % 64) / 2; }
__host__ __device__ __forceinline__ int perm32(int rho) { const int n = rho >> 4, i = rho & 15; return 8 * (i >> 2) + 4 * n + (i & 3); }

struct Unit { int pm, pn, ks; };
struct Gemm { const bf16_t* A; const bf16_t* Bt; int M, N, K; };
struct StaticOrder {
    int nM, nN, nwg, G, c;
    __host__ __device__ void init(int M, int N, int G_, int c_) { nM = M / BM; nN = N / BM; nwg = nM * nN; G = G_; c = c_; }
    __host__ __device__ bool next(int i, Unit& u) const {
        const long L = (long)i * G + c; if (L >= nwg) return false;
        int wgid = (int)L; { const int q = nwg / NXCD, r = nwg % NXCD, xcd = wgid % NXCD, off = wgid / NXCD; wgid = (xcd < r ? xcd * (q + 1) : r * (q + 1) + (xcd - r) * q) + off; }
        const int nig = WGM * nN, gid = wgid / nig, fm = gid * WGM, gsz = (nM - fm) < WGM ? (nM - fm) : WGM;
        u.pm = fm + ((wgid % nig) % gsz); u.pn = (wgid % nig) / gsz; return true;
    }
    __device__ __forceinline__ void a_ready(const Unit&) const {}
    __device__ __forceinline__ void done(const Unit&) const {}
};
__device__ __forceinline__ unsigned cvt_pk_bf16(float lo, float hi) { unsigned r; asm volatile("v_cvt_pk_bf16_f32 %0, %1, %2" : "=v"(r) : "v"(lo), "v"(hi)); return r; }
typedef float f32x2 __attribute__((ext_vector_type(2)));

template <class Epi, class Sched, bool ALIGN_EPI = false, bool SP2 = false, bool GATHER = false, bool SPLITK = false, bool F8 = false>
__device__ __forceinline__ void gemm_phase(PG8_LAS unsigned char* lds, const Gemm g, const Sched& S, const Epi& E) {
    const int tid = threadIdx.x, wid = __builtin_amdgcn_readfirstlane(tid >> 6), lane = tid & 63, wr = wid >> 2, wc = wid & 3, fr = lane & 15, fq = lane >> 4;
    int K = g.K; asm volatile("" : "+s"(K));
    int nt = K / BK;
    unsigned voffA[2], voffB[2]; int gR[2]; unsigned gC2[2];
#pragma unroll
    for (int i = 0; i < 2; ++i) { int R, C; stage_rc(tid * 16 + i * 8192, R, C); const int Rb = Epi::PERM ? ((R & ~31) + perm32(R & 31)) : R;
        voffA[i] = (unsigned)(R * K + C) * 2u; voffB[i] = (unsigned)(Rb * K + C) * 2u; gR[i] = R; gC2[i] = (unsigned)C * 2u; }
    const size_t kstep = (size_t)(BK * 2);
    const size_t hstep = (size_t)HALF * K * 2;
    const size_t tstep = 2 * hstep;
    const unsigned ldsw = (unsigned)wid * 1024u;
    const int aoff = lds_byte(wr * 64 + fr, fq * 8), boff = lds_byte(wc * 32 + fr, fq * 8);
#define PG8_SA(b, h) (((b) * 2 + (h)) * HTB)
#define PG8_SB(b, h) ((4 + (b) * 2 + (h)) * HTB)
#define PG8_STAGE(bufoff, gbase, voff) do { _Pragma("unroll") for (int _i = 0; _i < 2; ++_i) \
        __builtin_amdgcn_global_load_lds((const unsigned*)((const char*)(gbase) + (voff)[_i]), (PG8_LAS unsigned*)(lds + (bufoff) + ldsw + _i * 8192), 16, 0, 0); } while (0)
#define PG8_LDA(dst, b, h) do { if constexpr (F8) { _Pragma("unroll") for (int m = 0; m < 4; ++m) { const bf16x8 lo_ = *(const PG8_LAS bf16x8*)(lds + PG8_SA(b, h) + aoff + m * 2048), hi_ = *(const PG8_LAS bf16x8*)(lds + PG8_SA(b, h) + aoff + m * 2048 + 1024); \
            dst##8[m] = __builtin_bit_cast(v8i32, __builtin_shufflevector(lo_, hi_, 0, 1, 2, 3, 4, 5, 6, 7, 8, 9, 10, 11, 12, 13, 14, 15)); } } \
        else { _Pragma("unroll") for (int m = 0; m < 4; ++m) _Pragma("unroll") for (int k = 0; k < 2; ++k) dst[m][k] = *(const PG8_LAS bf16x8*)(lds + PG8_SA(b, h) + aoff + m * 2048 + k * 1024); } } while (0)
#define PG8_LDB(dst, b, h) do { if constexpr (F8) { _Pragma("unroll") for (int n = 0; n < 2; ++n) { const bf16x8 lo_ = *(const PG8_LAS bf16x8*)(lds + PG8_SB(b, h) + boff + n * 2048), hi_ = *(const PG8_LAS bf16x8*)(lds + PG8_SB(b, h) + boff + n * 2048 + 1024); \
            dst##8[n] = __builtin_bit_cast(v8i32, __builtin_shufflevector(lo_, hi_, 0, 1, 2, 3, 4, 5, 6, 7, 8, 9, 10, 11, 12, 13, 14, 15)); } } \
        else { _Pragma("unroll") for (int n = 0; n < 2; ++n) _Pragma("unroll") for (int k = 0; k < 2; ++k) dst[n][k] = *(const PG8_LAS bf16x8*)(lds + PG8_SB(b, h) + boff + n * 2048 + k * 1024); } } while (0)
#define PG8_MMA(ai, bj, At, Bt) do { __builtin_amdgcn_s_setprio(1); _Pragma("unroll") for (int m = 0; m < 4; ++m) _Pragma("unroll") for (int n = 0; n < 2; ++n) { \
        if constexpr (F8) { acc[ai][bj][m][n] = __builtin_amdgcn_mfma_scale_f32_16x16x128_f8f6f4(Bt##8[n], At##8[m], acc[ai][bj][m][n], 0, 0, 0, 0x7f7f7f7f, 0, 0x7f7f7f7f); } \
        else { _Pragma("unroll") for (int k = 0; k < 2; ++k) acc[ai][bj][m][n] = __builtin_amdgcn_mfma_f32_16x16x32_bf16(Bt[n][k], At[m][k], acc[ai][bj][m][n], 0, 0, 0); } } \
        __builtin_amdgcn_s_setprio(0); \
        } while (0)
#define PG8_WAIT_V(n) asm volatile("s_waitcnt vmcnt(" #n ")" ::: "memory")
#define PG8_WAIT_L(n) asm volatile("s_waitcnt lgkmcnt(" #n ")" ::: "memory")
#define PG8_BAR __builtin_amdgcn_s_barrier()
#define PG8_SCHED __builtin_amdgcn_sched_barrier(0)
    Unit cur, nxt; int ui = 0;
    if (!S.next(0, cur)) return;
    PG8_LAS unsigned* gtab = (PG8_LAS unsigned*)(lds + 131584);
    unsigned gAc[2][2] = {{0u, 0u}, {0u, 0u}}, gAn[2][2] = {{0u, 0u}, {0u, 0u}};
    if constexpr (GATHER) {
        for (int i = 0; i < 13; ++i) { Unit u; if (!S.next(i, u)) break; if (tid < 256) gtab[i * 256 + tid] = (unsigned)S.arow(u)[tid] * (unsigned)(K * 2); }
        __syncthreads();
#pragma unroll
        for (int h = 0; h < 2; ++h)
#pragma unroll
            for (int i = 0; i < 2; ++i) gAc[h][i] = gtab[h * 128 + gR[i]] + gC2[i];
    }
    f32x4 acc[2][2][4][2];
#pragma unroll
    for (int a = 0; a < 2; ++a)
#pragma unroll
        for (int b = 0; b < 2; ++b)
#pragma unroll
            for (int m = 0; m < 4; ++m)
#pragma unroll
                for (int n = 0; n < 2; ++n) acc[a][b][m][n] = (f32x4){0.f, 0.f, 0.f, 0.f};
    bf16x8 At[4][2], B0[2][2], B1[2][2];
    v8i32 At8[4], B08[2], B18[2];
    const char* cA = GATHER ? (const char*)g.A : (const char*)g.A + (size_t)cur.pm * tstep; const char* cB = (const char*)g.Bt + (size_t)cur.pn * tstep;
    if constexpr (SPLITK) { cA += (size_t)S.kofs(cur) * 2; cB += (size_t)S.kofs(cur) * 2; nt = S.klen(cur) / BK; }
#define PG8_STA(bufoff, p, h, arr) do { if constexpr (GATHER) { PG8_STAGE(bufoff, p, arr[h]); } else { PG8_STAGE(bufoff, (p) + (h) * hstep, voffA); } } while (0)
    S.a_ready(cur);
    if constexpr (SP2) {
        PG8_STAGE(PG8_SB(0, 0), cB, voffB); PG8_STAGE(PG8_SB(0, 1), cB + hstep, voffB); PG8_STA(PG8_SA(0, 0), cA, 0, gAc); PG8_STA(PG8_SA(0, 1), cA, 1, gAc);
        if (wr == 1) PG8_BAR;
        PG8_WAIT_V(2); PG8_BAR;
        PG8_STAGE(PG8_SB(1, 0), cB + kstep, voffB); PG8_STA(PG8_SA(1, 0), cA + kstep, 0, gAc); PG8_STAGE(PG8_SB(1, 1), cB + hstep + kstep, voffB);
        PG8_WAIT_V(6); PG8_BAR;
    } else {
        PG8_STAGE(PG8_SB(0, 0), cB, voffB); PG8_STAGE(PG8_SA(0, 0), cA, voffA); PG8_STAGE(PG8_SB(0, 1), cB + hstep, voffB); PG8_STAGE(PG8_SA(0, 1), cA + hstep, voffA);
        if (wr == 1) PG8_BAR;
        PG8_WAIT_V(4); PG8_BAR;
        PG8_STAGE(PG8_SB(1, 0), cB + kstep, voffB); PG8_STAGE(PG8_SA(1, 0), cA + kstep, voffA); PG8_STAGE(PG8_SB(1, 1), cB + hstep + kstep, voffB);
        PG8_WAIT_V(6); PG8_BAR;
    }
    for (;;) {
        const bool has_next = S.next(ui + 1, nxt);
        const char* nA = GATHER ? cA : (has_next ? (const char*)g.A + (size_t)nxt.pm * tstep : cA); const char* nB = has_next ? (const char*)g.Bt + (size_t)nxt.pn * tstep : cB;
        const char* nA2 = nA; const char* nB2 = nB;
        if constexpr (SPLITK) { if (has_next) { nA2 += (size_t)S.kofs(nxt) * 2; nB2 += (size_t)S.kofs(nxt) * 2; } }
        if constexpr (GATHER) {
#pragma unroll
            for (int h = 0; h < 2; ++h)
#pragma unroll
                for (int i = 0; i < 2; ++i) gAn[h][i] = has_next ? gtab[(ui + 1) * 256 + h * 128 + gR[i]] + gC2[i] : gAc[h][i];
        }
        if constexpr (F8) {
#pragma unroll 1
            for (int tt = 0; tt < nt; ++tt) {
                const int pb = tt & 1, ob = pb ^ 1, i1 = tt + 1, i2 = tt + 2;
                const char* p1A = i1 < nt ? cA + (size_t)i1 * kstep : nA2 + (size_t)(i1 - nt) * kstep;
                const char* p2A = i2 < nt ? cA + (size_t)i2 * kstep : nA2 + (size_t)(i2 - nt) * kstep;
                const char* p2B = i2 < nt ? cB + (size_t)i2 * kstep : nB2 + (size_t)(i2 - nt) * kstep;
                unsigned g1[2][2], g2[2][2];
#pragma unroll
                for (int h = 0; h < 2; ++h)
#pragma unroll
                    for (int i = 0; i < 2; ++i) { g1[h][i] = i1 < nt ? gAc[h][i] : gAn[h][i]; g2[h][i] = i2 < nt ? gAc[h][i] : gAn[h][i]; }
                PG8_LDB(B0, pb, 0); PG8_LDB(B1, pb, 1); PG8_SCHED; PG8_LDA(At, pb, 0); PG8_STA(PG8_SA(ob, 1), p1A, 1, g1);
                PG8_WAIT_V(8); PG8_WAIT_L(0); PG8_BAR; PG8_MMA(0, 0, At, B0); PG8_MMA(0, 1, At, B1); PG8_BAR; PG8_SCHED;
                PG8_LDA(At, pb, 1); PG8_STAGE(PG8_SB(pb, 0), p2B, voffB); PG8_STAGE(PG8_SB(pb, 1), p2B + hstep, voffB); PG8_STA(PG8_SA(pb, 0), p2A, 0, g2);
                PG8_WAIT_V(8); PG8_WAIT_L(0); PG8_BAR; PG8_MMA(1, 0, At, B0); PG8_MMA(1, 1, At, B1); PG8_BAR; PG8_SCHED;
            }
        } else {
#pragma unroll 1
        for (int t = 0; t < nt; t += 2) {
            const bool last = (t == nt - 2);
            const char* a1 = cA + (size_t)(t + 1) * kstep;
            const char* a2 = last ? nA2 : cA + (size_t)(t + 2) * kstep; const char* b2 = last ? nB2 : cB + (size_t)(t + 2) * kstep;
            const char* a3 = a2 + kstep; const char* b3 = b2 + kstep;
            unsigned gS[2][2];
#pragma unroll
            for (int h = 0; h < 2; ++h)
#pragma unroll
                for (int i = 0; i < 2; ++i) gS[h][i] = last ? gAn[h][i] : gAc[h][i];
            if (last && has_next) S.a_ready(nxt);
            if constexpr (SP2) {
            PG8_LDB(B0, 0, 0); PG8_LDB(B1, 0, 1); PG8_SCHED; PG8_LDA(At, 0, 0); PG8_STA(PG8_SA(1, 1), a1, 1, gAc);
            PG8_WAIT_V(8); PG8_WAIT_L(0); PG8_BAR; PG8_MMA(0, 0, At, B0); PG8_MMA(0, 1, At, B1); PG8_BAR; PG8_SCHED;
            PG8_LDA(At, 0, 1); PG8_STAGE(PG8_SB(0, 0), b2, voffB); PG8_STAGE(PG8_SB(0, 1), b2 + hstep, voffB); PG8_STA(PG8_SA(0, 0), a2, 0, gS);
            PG8_WAIT_V(8); PG8_WAIT_L(0); PG8_BAR; PG8_MMA(1, 0, At, B0); PG8_MMA(1, 1, At, B1); PG8_BAR; PG8_SCHED;
            PG8_LDB(B0, 1, 0); PG8_LDB(B1, 1, 1); PG8_SCHED; PG8_LDA(At, 1, 0); PG8_STA(PG8_SA(0, 1), a2, 1, gS);
            PG8_WAIT_V(8); PG8_WAIT_L(0); PG8_BAR; PG8_MMA(0, 0, At, B0); PG8_MMA(0, 1, At, B1); PG8_BAR; PG8_SCHED;
            PG8_LDA(At, 1, 1); PG8_STAGE(PG8_SB(1, 0), b3, voffB); PG8_STAGE(PG8_SB(1, 1), b3 + hstep, voffB); PG8_STA(PG8_SA(1, 0), a3, 0, gS);
            PG8_WAIT_V(8); PG8_WAIT_L(0); PG8_BAR; PG8_MMA(1, 0, At, B0); PG8_MMA(1, 1, At, B1); PG8_BAR; PG8_SCHED;
            } else {
            PG8_LDB(B0, 0, 0); PG8_SCHED; PG8_LDA(At, 0, 0); PG8_STAGE(PG8_SA(1, 1), a1 + hstep, voffA);
            PG8_WAIT_L(8); PG8_BAR; PG8_WAIT_L(0); PG8_MMA(0, 0, At, B0); PG8_BAR; PG8_SCHED;
            PG8_LDB(B1, 0, 1); PG8_STAGE(PG8_SB(0, 0), b2, voffB);
            PG8_BAR; PG8_WAIT_L(0); PG8_MMA(0, 1, At, B1); PG8_BAR;
            PG8_LDA(At, 0, 1); PG8_STAGE(PG8_SA(0, 0), a2, voffA);
            PG8_BAR; PG8_WAIT_L(0); PG8_MMA(1, 0, At, B0); PG8_BAR; PG8_SCHED;
            PG8_STAGE(PG8_SB(0, 1), b2 + hstep, voffB);
            PG8_WAIT_V(6); PG8_BAR; PG8_MMA(1, 1, At, B1); PG8_BAR;
            PG8_LDB(B0, 1, 0); PG8_SCHED; PG8_LDA(At, 1, 0); PG8_STAGE(PG8_SA(0, 1), a2 + hstep, voffA);
            PG8_WAIT_L(8); PG8_BAR; PG8_WAIT_L(0); PG8_MMA(0, 0, At, B0); PG8_BAR; PG8_SCHED;
            PG8_LDB(B1, 1, 1); PG8_STAGE(PG8_SB(1, 0), b3, voffB);
            PG8_BAR; PG8_WAIT_L(0); PG8_MMA(0, 1, At, B1); PG8_BAR;
            PG8_LDA(At, 1, 1); PG8_STAGE(PG8_SA(1, 0), a3, voffA);
            PG8_BAR; PG8_WAIT_L(0); PG8_MMA(1, 0, At, B0); PG8_BAR; PG8_SCHED;
            PG8_STAGE(PG8_SB(1, 1), b3 + hstep, voffB);
            PG8_WAIT_V(6); PG8_BAR; PG8_MMA(1, 1, At, B1); PG8_BAR;
            }
        }
        }
        if constexpr (ALIGN_EPI) { if (wr == 0) PG8_BAR; }
        if constexpr (!Epi::AFTER_DRAIN) { E(acc, cur, wr, wc, fr, fq); S.done(cur); }
        if (!has_next) break;
#pragma unroll
        for (int a = 0; a < 2; ++a)
#pragma unroll
            for (int b = 0; b < 2; ++b)
#pragma unroll
                for (int m = 0; m < 4; ++m)
#pragma unroll
                    for (int n = 0; n < 2; ++n) acc[a][b][m][n] = (f32x4){0.f, 0.f, 0.f, 0.f};
        cur = nxt; cA = nA2; cB = nB2; ++ui;
        if constexpr (SPLITK) nt = S.klen(cur) / BK;
        if constexpr (GATHER) {
#pragma unroll
            for (int h = 0; h < 2; ++h)
#pragma unroll
                for (int i = 0; i < 2; ++i) gAc[h][i] = gAn[h][i]; }
        if constexpr (ALIGN_EPI) { if (wr == 1) PG8_BAR; }
    }
    PG8_WAIT_V(0);
    if constexpr (!ALIGN_EPI) { if (wr == 0) PG8_BAR; }
    PG8_BAR;
    if constexpr (Epi::AFTER_DRAIN) { E.fused(acc, cur, wr, wc, fr, fq, lds, wid, lane); S.done(cur); }
#undef PG8_SA
#undef PG8_SB
#undef PG8_STAGE
#undef PG8_STA
#undef PG8_LDA
#undef PG8_LDB
#undef PG8_MMA
#undef PG8_WAIT_V
#undef PG8_WAIT_L
#undef PG8_BAR
#undef PG8_SCHED
}
}

typedef unsigned short bf16_t;
typedef short v4i16_t __attribute__((ext_vector_type(4)));
typedef unsigned u32x4_t __attribute__((ext_vector_type(4)));
typedef unsigned u32x2_t __attribute__((ext_vector_type(2)));
typedef pg8::f32x4 f32x4;
__device__ __forceinline__ unsigned pk_bf16(float lo, float hi) { return pg8::cvt_pk_bf16(lo, hi); }
__device__ __forceinline__ float bf2f(bf16_t v) { return __builtin_bit_cast(float, (unsigned)v << 16); }
__device__ __forceinline__ unsigned pk4_fp8(float a, float b, float c, float d) { int w = 0; w = __builtin_amdgcn_cvt_pk_fp8_f32(a, b, w, false); w = __builtin_amdgcn_cvt_pk_fp8_f32(c, d, w, true); return (unsigned)w; }
constexpr float W8_SCALE = 64.f, W8_INV = 1.f / 64.f;
__device__ __forceinline__ float fast_silu(float x) { return x * __builtin_amdgcn_rcpf(1.f + __expf(-x)); }
__device__ __forceinline__ float wave_sum(float v) {
#pragma unroll
    for (int o = 1; o < 64; o <<= 1) v += __shfl_xor(v, o);
    return v;
}
__device__ __forceinline__ float siluf(float x) { return x / (1.f + expf(-x)); }
__device__ __forceinline__ float sigmoidf(float x) { return 1.f / (1.f + expf(-x)); }
__device__ __forceinline__ float log_sigmoidf(float x) { return fminf(x, 0.f) - log1pf(expf(-fabsf(x))); }
__device__ __forceinline__ int mod_index(int r) { const int b = r / TT; return (r - b * TT) < CTX ? 8 : b; }

template <class Map, bool F8OUT = false>
__device__ __forceinline__ void conv_item(const float* W, int ldw, int ncols, int K, int k0, int n0, bf16_t* WT, const Map& map, const float* kscale, LAS unsigned char* scr, int lane, float wscale = 1.f) {
    const int lr = lane >> 4, lc = (lane & 15) * 4;
    const bool cvalid = (n0 + lc) < ncols;
    float4 v[16];
#pragma unroll
    for (int i = 0; i < 16; ++i) { v[i] = make_float4(0.f, 0.f, 0.f, 0.f); if (cvalid) v[i] = *(const float4*)(W + (size_t)(k0 + 4 * i + lr) * ldw + n0 + lc); }
#pragma unroll
    for (int i = 0; i < 16; ++i) { const float sc = (kscale ? kscale[k0 + 4 * i + lr] : 1.f) * wscale;
        u32x2_t w; w.x = pk_bf16(v[i].x * sc, v[i].y * sc); w.y = pk_bf16(v[i].z * sc, v[i].w * sc);
        *(LAS u32x2_t*)(scr + (4 * i + lr) * 144 + (lane & 15) * 8) = w; }
    asm volatile("s_waitcnt lgkmcnt(0)" ::: "memory");
    const int g = lane >> 4, q = (lane >> 2) & 3, p = lane & 3, i16 = lane & 15;
#pragma unroll
    for (int s2 = 0; s2 < 8; ++s2) { const int nb = s2 >> 1, kc = (s2 & 1) * 4 + g;
        LAS unsigned char* a = scr + (kc * 8 + q) * 144 + (nb * 16 + 4 * p) * 2;
        const v4i16_t lo = __builtin_amdgcn_ds_read_tr16_b64_v4i16((LAS v4i16_t*)a), hi = __builtin_amdgcn_ds_read_tr16_b64_v4i16((LAS v4i16_t*)(a + 4 * 144));
        const int sc = n0 + nb * 16 + i16, drow = sc < ncols ? map(sc) : -1;
        u32x4_t o; const u32x2_t l2 = __builtin_bit_cast(u32x2_t, lo), h2 = __builtin_bit_cast(u32x2_t, hi); o.x = l2.x; o.y = l2.y; o.z = h2.x; o.w = h2.y;
        if constexpr (F8OUT) {
            u32x2_t o8;
            o8.x = pk4_fp8(__builtin_bit_cast(float, o.x << 16), __builtin_bit_cast(float, o.x & 0xffff0000u), __builtin_bit_cast(float, o.y << 16), __builtin_bit_cast(float, o.y & 0xffff0000u));
            o8.y = pk4_fp8(__builtin_bit_cast(float, o.z << 16), __builtin_bit_cast(float, o.z & 0xffff0000u), __builtin_bit_cast(float, o.w << 16), __builtin_bit_cast(float, o.w & 0xffff0000u));
            if (drow >= 0) *(u32x2_t*)((unsigned char*)WT + (size_t)drow * K + k0 + kc * 8) = o8;
        } else {
            if (drow >= 0) *(u32x4_t*)(WT + (size_t)drow * K + k0 + kc * 8) = o;
        } }
    asm volatile("s_waitcnt lgkmcnt(0)" ::: "memory");
}
template <class Map>
__device__ __forceinline__ void conv_item_tall8(const float* W, int ldw, int K, int k0, int n0, unsigned char* WT8, const Map& map, LAS unsigned char* scr, int lane, float wscale) {
    const int lr = lane >> 3, lc = (lane & 7) * 4;
    float4 v[16];
#pragma unroll
    for (int i = 0; i < 16; ++i) v[i] = *(const float4*)(W + (size_t)(k0 + 8 * i + lr) * ldw + n0 + lc);
#pragma unroll
    for (int i = 0; i < 16; ++i) { u32x2_t w; w.x = pk_bf16(v[i].x * wscale, v[i].y * wscale); w.y = pk_bf16(v[i].z * wscale, v[i].w * wscale);
        *(LAS u32x2_t*)(scr + (8 * i + lr) * 80 + (lane & 7) * 8) = w; }
    asm volatile("s_waitcnt lgkmcnt(0)" ::: "memory");
    const int g = lane >> 4, q = (lane >> 2) & 3, p = lane & 3, i16 = lane & 15;
#pragma unroll
    for (int s2 = 0; s2 < 4; ++s2) { const int nb = s2 >> 1, hk = s2 & 1;
        LAS unsigned char* a = scr + (64 * hk + 16 * g + q) * 80 + (nb * 16 + 4 * p) * 2;
        u32x4_t o8;
#pragma unroll
        for (int m = 0; m < 4; ++m) { const v4i16_t t4 = __builtin_amdgcn_ds_read_tr16_b64_v4i16((LAS v4i16_t*)(a + 4 * m * 80)); const u32x2_t t2 = __builtin_bit_cast(u32x2_t, t4);
            o8[m] = pk4_fp8(__builtin_bit_cast(float, t2.x << 16), __builtin_bit_cast(float, t2.x & 0xffff0000u), __builtin_bit_cast(float, t2.y << 16), __builtin_bit_cast(float, t2.y & 0xffff0000u)); }
        const int drow = map(n0 + nb * 16 + i16);
        *(u32x4_t*)(WT8 + (size_t)drow * K + k0 + 64 * hk + 16 * g) = o8; }
    asm volatile("s_waitcnt lgkmcnt(0)" ::: "memory");
}
constexpr int N_L1ITEMS = 2 * 16 * 3 * 704;
struct ConvItem { const float* W; unsigned char* WT8; int ldw, K, which, k0, n0; };
struct ConvCtx { const float* wg; const float* wu; const float* wd; unsigned char* WGU8; unsigned char* WDT8; int n, stride, offset; };
constexpr int N_TAIL2 = 120 * 8 * 4, N_TAIL10 = 160 * 8 * 2, N_TAIL14 = 56 * 8 * 4, N_TAILITEMS = N_TAIL2 + N_TAIL10 + N_TAIL14, N_ATTITEMS = N_L1ITEMS - N_TAILITEMS;
__device__ __forceinline__ int conv_att_limit(const ConvCtx& c) { return c.stride == 2048 ? N_ATTITEMS : N_L1ITEMS; }
__device__ __forceinline__ int conv_item_index(const ConvCtx& c, int n) {
    if (c.stride != 2048) return n * c.stride + c.offset;
    if (n < 21) return n * 2048 + c.offset;
    if (n < 26) return c.offset >= 256 ? 43008 + (n - 21) * 1792 + (c.offset - 256) : (1 << 30);
    return c.offset >= 768 ? 51968 + (n - 26) * 1280 + (c.offset - 768) : (1 << 30);
}
__device__ __forceinline__ ConvItem conv_decode_l1(const ConvCtx& c, int item) {
    const int le = item / 2112, r2 = item % 2112, which = r2 / 704, q = r2 - which * 704;
    ConvItem it; it.which = which;
    if (which < 2) { const int kb = q / 44, nbk = q - kb * 44; it.W = (which ? c.wu : c.wg) + (size_t)le * D * FF; it.ldw = FF; it.K = D; it.WT8 = c.WGU8 + (size_t)le * 5632 * D; it.k0 = kb * 64; it.n0 = nbk * 64; }
    else { const int kb = q / 16, nbk = q - kb * 16; it.W = c.wd + (size_t)le * FF * D; it.ldw = D; it.K = FF; it.WT8 = c.WDT8 + (size_t)le * D * FF; it.k0 = kb * 64; it.n0 = nbk * 64; }
    return it;
}
__device__ __forceinline__ void conv_q_issue(const ConvItem& it, int q, float4 (&cv)[8], int lane) {
    const float* src = it.W + (size_t)(it.k0 + 32 * q + (lane >> 4)) * it.ldw + it.n0 + (lane & 15) * 4;
#pragma unroll
    for (int i = 0; i < 8; ++i) { const f32x4 t = __builtin_nontemporal_load((const f32x4*)(src + (size_t)(4 * i) * it.ldw)); cv[i] = make_float4(t[0], t[1], t[2], t[3]); }
}
__device__ __forceinline__ void conv_q_stash(int q, const float4 (&cv)[8], LAS unsigned char* scr, int lane) {
#pragma unroll
    for (int i = 0; i < 8; ++i) { u32x2_t w; w.x = pk_bf16(cv[i].x * W8_SCALE, cv[i].y * W8_SCALE); w.y = pk_bf16(cv[i].z * W8_SCALE, cv[i].w * W8_SCALE);
        *(LAS u32x2_t*)(scr + (32 * q + 4 * i + (lane >> 4)) * 144 + (lane & 15) * 8) = w; }
}
__device__ __forceinline__ void conv_finish(const ConvItem& it, LAS unsigned char* scr, int lane) {
    asm volatile("s_waitcnt lgkmcnt(0)" ::: "memory");
    const int g = lane >> 4, q = (lane >> 2) & 3, p = lane & 3, i16 = lane & 15;
#pragma unroll
    for (int nb = 0; nb < 4; ++nb) {
        LAS unsigned char* a = scr + (16 * g + q) * 144 + (nb * 16 + 4 * p) * 2;
        u32x4_t o8;
#pragma unroll
        for (int m = 0; m < 4; ++m) { const v4i16_t t4 = __builtin_amdgcn_ds_read_tr16_b64_v4i16((LAS v4i16_t*)(a + 4 * m * 144)); const u32x2_t t2 = __builtin_bit_cast(u32x2_t, t4);
            o8[m] = pk4_fp8(__builtin_bit_cast(float, t2.x << 16), __builtin_bit_cast(float, t2.x & 0xffff0000u), __builtin_bit_cast(float, t2.y << 16), __builtin_bit_cast(float, t2.y & 0xffff0000u)); }
        const int n = it.n0 + nb * 16 + i16, drow = it.which < 2 ? (n >> 7) * 256 + it.which * 128 + (n & 127) : n;
        __builtin_nontemporal_store(o8, (u32x4_t*)(it.WT8 + (size_t)drow * it.K + it.k0 + 16 * g)); }
    asm volatile("s_waitcnt lgkmcnt(0)" ::: "memory");
}
__device__ __forceinline__ void conv_tail(const ConvCtx& c, LAS unsigned char* ldsl, int base, int per_wave, int widx, int nw, int limit) {
    const int lane = threadIdx.x & 63; LAS unsigned char* scr = ldsl + __builtin_amdgcn_readfirstlane(threadIdx.x >> 6) * 10240;
#pragma unroll 1
    for (int j = 0; j < per_wave; ++j) { const int item = base + j * nw + widx; if (item >= limit) break;
        const ConvItem it = conv_decode_l1(c, item); float4 cv0[8], cv1[8];
        conv_q_issue(it, 0, cv0, lane); conv_q_issue(it, 1, cv1, lane);
        conv_q_stash(0, cv0, scr, lane); conv_q_stash(1, cv1, scr, lane);
        conv_finish(it, scr, lane); }
}
__device__ __forceinline__ int ilv32(int i) { return i < 32 ? 2 * i : 2 * (i - 32) + 1; }
__device__ __forceinline__ int ilv16(int j) { return j < 16 ? 2 * j : 2 * (j - 16) + 1; }
struct MapIdent { __device__ __forceinline__ int operator()(int c) const { return c; } };
struct MapGateUp { int half; __device__ __forceinline__ int operator()(int f) const { return (f >> 7) * 256 + half * 128 + (f & 127); } };
struct MapAttIn { __device__ __forceinline__ int operator()(int c) const { if (c < 1024) return (c & ~63) + ilv32(c & 63); if (c < 2176) return c; return 2176 + ilv16(c - 2176); } };
struct MapQUp { __device__ __forceinline__ int operator()(int c) const { const int h = c / 96, d = c - h * 96; return d < 64 ? h * 64 + d : 512 + h * 32 + ilv16(d - 64); } };
struct MapKVUp { __device__ __forceinline__ int operator()(int c) const { const int h = c >> 7, d = c & 127; return d < 64 ? h * 64 + d : 512 + h * 64 + (d - 64); } };
struct MapRecIn { __device__ __forceinline__ int operator()(int c) const { return c < 1536 ? c : (c < 1568 ? 4096 + (c - 1536) : c - 32); } };

struct OrderShareB {
    int nMe, nNe, npairs, G, c; const int* AROWp;
    __device__ __forceinline__ const int* arow(const pg8::Unit& u) const { const int e = u.pm / nMe; return AROWp + e * MEXP + (u.pm - e * nMe) * 256; }
    __device__ __forceinline__ bool next(int i, pg8::Unit& u) const {
        long j; int x;
        if ((G & 7) == 0) { x = c & 7; j = (long)i * (G >> 3) + (c >> 3); } else { x = 0; j = -1; }
        int pair, pml;
        if (j >= 0) { pair = (int)(j / nMe) * 8 + x; pml = (int)(j % nMe); } else { const long L = (long)i * G + c; pair = (int)(L / nMe); pml = (int)(L % nMe); }
        if (pair >= npairs) return false;
        const int e = pair / nNe, pnl = pair - e * nNe; u.pm = e * nMe + pml; u.pn = e * nNe + pnl; u.ks = 0; return true;
    }
    __device__ __forceinline__ void a_ready(const pg8::Unit&) const {}
    __device__ __forceinline__ void done(const pg8::Unit&) const {}
};
struct OrderShareA {
    int nMe, nNe, npairs, G, c, nMl;
    __device__ __forceinline__ bool next(int i, pg8::Unit& u) const {
        long j; int x;
        if ((G & 7) == 0) { x = c & 7; j = (long)i * (G >> 3) + (c >> 3); } else { x = 0; j = -1; }
        int pair, pnl;
        if (j >= 0) { pair = (int)(j / nNe) * 8 + x; pnl = (int)(j % nNe); } else { const long L = (long)i * G + c; pair = (int)(L / nNe); pnl = (int)(L % nNe); }
        if (pair >= npairs) return false;
        const int e = pair / nMl, pml = pair - e * nMl; u.pm = e * nMe + pml; u.pn = e * nNe + pnl; u.ks = 0; return true;
    }
    __device__ __forceinline__ void a_ready(const pg8::Unit&) const {}
    __device__ __forceinline__ void done(const pg8::Unit&) const {}
};
struct OrderCtxSplitK {
    int G, c;
    __device__ __forceinline__ bool next(int i, pg8::Unit& u) const {
        const long L = (long)i * G + c; if (L >= 256) return false;
        const int e = (int)L >> 4, rem = (int)L & 15; u.pm = e * 9 + 8; u.pn = e * 4 + (rem >> 2); u.ks = rem & 3; return true;
    }
    __device__ __forceinline__ int kofs(const pg8::Unit& u) const { return u.ks * 384; }
    __device__ __forceinline__ int klen(const pg8::Unit& u) const { return u.ks < 3 ? 384 : 256; }
    __device__ __forceinline__ void a_ready(const pg8::Unit&) const {}
    __device__ __forceinline__ void done(const pg8::Unit&) const {}
};
struct LatentOrder : pg8::StaticOrder {
    __device__ __forceinline__ bool next(int i, pg8::Unit& u) const { if (!pg8::StaticOrder::next(i, u)) return false; u.pm = (u.pm >> 3) * 9 + 1 + (u.pm & 7); return true; }
};


struct OrderCtxSplitK4 {
    int G, c;
    __device__ __forceinline__ bool next(int i, pg8::Unit& u) const {
        const long L = (long)i * G + c; if (L >= 128) return false;
        const int b = (int)L >> 4, rem = (int)L & 15; u.pm = b * 9; u.pn = rem >> 2; u.ks = rem & 3; return true;
    }
    __device__ __forceinline__ int kofs(const pg8::Unit& u) const { return u.ks * 256; }
    __device__ __forceinline__ int klen(const pg8::Unit&) const { return 256; }
    __device__ __forceinline__ void a_ready(const pg8::Unit&) const {}
    __device__ __forceinline__ void done(const pg8::Unit&) const {}
};

__device__ __forceinline__ u32x4_t pack8(f32x4 a0, f32x4 a1, float s);
struct EpiSwiGLU {
    static constexpr bool PERM = true, AFTER_DRAIN = false;
    unsigned char* HID; int nMe;
    __device__ __forceinline__ void operator()(const f32x4 (&acc)[2][2][4][2], const pg8::Unit& u, int wr, int wc, int fr, int fq) const {
        const int e = u.pm / nMe, pnl = u.pn - e * 22;
        const int row0 = u.pm * 256 + wr * 64 + fr, col0 = pnl * 128 + wc * 32 + 8 * fq;
#pragma unroll
        for (int ai = 0; ai < 2; ++ai)
#pragma unroll
            for (int m = 0; m < 4; ++m) {
                const f32x4 g0 = acc[ai][0][m][0], g1 = acc[ai][0][m][1], u0 = acc[ai][1][m][0], u1 = acc[ai][1][m][1];
                float hv[8];
#pragma unroll
                for (int j = 0; j < 4; ++j) {
                    const float r0 = __builtin_amdgcn_rcpf(fmaf(__builtin_amdgcn_exp2f(g0[j] * (-W8_INV * 1.44269504f)), 4096.f, 4096.f)), r1 = __builtin_amdgcn_rcpf(fmaf(__builtin_amdgcn_exp2f(g1[j] * (-W8_INV * 1.44269504f)), 4096.f, 4096.f));
                    hv[j] = __builtin_amdgcn_fmed3f(g0[j] * u0[j] * r0, -448.f, 448.f); hv[4 + j] = __builtin_amdgcn_fmed3f(g1[j] * u1[j] * r1, -448.f, 448.f); }
                u32x2_t w; w.x = pk4_fp8(hv[0], hv[1], hv[2], hv[3]); w.y = pk4_fp8(hv[4], hv[5], hv[6], hv[7]);
                *(u32x2_t*)(HID + (size_t)(row0 + ai * 128 + m * 16) * FF + col0) = w; }
    }
};
struct EpiDownGate {
    static constexpr bool PERM = true, AFTER_DRAIN = false;
    bf16_t* Y; const float* GATE; int nMe;
    __device__ __forceinline__ void operator()(const f32x4 (&acc)[2][2][4][2], const pg8::Unit& u, int wr, int wc, int fr, int fq) const {
        const int e = u.pm / nMe, pnl = u.pn - e * 4, ml0 = (u.pm - e * nMe) * 256 + wr * 64 + fr;
        const int row0 = u.pm * 256 + wr * 64 + fr, col0 = pnl * 256 + wc * 32 + 8 * fq;
        float gts[2][4];
#pragma unroll
        for (int ai = 0; ai < 2; ++ai)
#pragma unroll
            for (int m = 0; m < 4; ++m) gts[ai][m] = GATE[e * MEXP + ml0 + ai * 128 + m * 16] * W8_INV;
#pragma unroll
        for (int ai = 0; ai < 2; ++ai)
#pragma unroll
            for (int m = 0; m < 4; ++m) { const float gt = gts[ai][m]; bf16_t* rowp = Y + (size_t)(row0 + ai * 128 + m * 16) * D + col0;
#pragma unroll
                for (int bj = 0; bj < 2; ++bj) *(u32x4_t*)(rowp + bj * 128) = pack8(acc[ai][bj][m][0], acc[ai][bj][m][1], gt); }
    }
};
struct EpiDownCtxPart {
    static constexpr bool PERM = true, AFTER_DRAIN = false;
    bf16_t* Y2; const float* GATE;
    __device__ __forceinline__ void operator()(const f32x4 (&acc)[2][2][4][2], const pg8::Unit& u, int wr, int wc, int fr, int fq) const {
        const int e = u.pm / 9, pnl = u.pn - e * 4, ml0 = wr * 64 + fr, col0 = pnl * 256 + wc * 32 + 8 * fq;
        bf16_t* base = Y2 + ((size_t)u.ks * NE + e) * 256 * D;
        const float* gbase = GATE + e * MEXP + 2048;
#pragma unroll
        for (int ai = 0; ai < 2; ++ai)
#pragma unroll
            for (int m = 0; m < 4; ++m) { const int sl = ml0 + ai * 128 + m * 16; const float gt = gbase[sl] * W8_INV;
                const unsigned off = (unsigned)(sl * D + col0);
#pragma unroll
                for (int bj = 0; bj < 2; ++bj) *(u32x4_t*)(base + off + bj * 128) = pack8(acc[ai][bj][m][0], acc[ai][bj][m][1], gt);
                asm volatile("" ::: "memory"); }
    }
};
struct EpiCtxPart {
    static constexpr bool PERM = true, AFTER_DRAIN = false;
    bf16_t* CP;
    __device__ __forceinline__ void operator()(const f32x4 (&acc)[2][2][4][2], const pg8::Unit& u, int wr, int wc, int fr, int fq) const {
        const int b = u.pm / 9, ml0 = wr * 64 + fr, col0 = u.pn * 256 + wc * 32 + 8 * fq;
        bf16_t* base = CP + ((size_t)u.ks * NB + b) * 256 * D;
#pragma unroll
        for (int ai = 0; ai < 2; ++ai)
#pragma unroll
            for (int m = 0; m < 4; ++m) { const unsigned off = (unsigned)((ml0 + ai * 128 + m * 16) * D + col0);
#pragma unroll
                for (int bj = 0; bj < 2; ++bj) *(u32x4_t*)(base + off + bj * 128) = pack8(acc[ai][bj][m][0], acc[ai][bj][m][1], 1.f);
                asm volatile("" ::: "memory"); }
    }
};
__device__ __forceinline__ u32x4_t rope8(f32x4 a0, f32x4 a1, const float2* tb, float s) {
    const f32x4 t0 = *(const f32x4*)tb, t1 = *(const f32x4*)(tb + 2);
    u32x4_t w;
    w.x = pk_bf16((a0[0] * t0[0] - a0[1] * t0[1]) * s, (a0[1] * t0[0] + a0[0] * t0[1]) * s);
    w.y = pk_bf16((a0[2] * t0[2] - a0[3] * t0[3]) * s, (a0[3] * t0[2] + a0[2] * t0[3]) * s);
    w.z = pk_bf16((a1[0] * t1[0] - a1[1] * t1[1]) * s, (a1[1] * t1[0] + a1[0] * t1[1]) * s);
    w.w = pk_bf16((a1[2] * t1[2] - a1[3] * t1[3]) * s, (a1[3] * t1[2] + a1[2] * t1[3]) * s);
    return w;
}
__device__ __forceinline__ u32x4_t pack8(f32x4 a0, f32x4 a1, float s) {
    u32x4_t w; w.x = pk_bf16(a0[0] * s, a0[1] * s); w.y = pk_bf16(a0[2] * s, a0[3] * s); w.z = pk_bf16(a1[0] * s, a1[1] * s); w.w = pk_bf16(a1[2] * s, a1[3] * s); return w;
}
struct EpiAttnIn {
    static constexpr bool PERM = true, AFTER_DRAIN = false;
    bf16_t *QK, *V1, *CQ, *CKV, *KR; float* SSQ; const float2* RDA; const float2* RR;
    __device__ __forceinline__ void operator()(const f32x4 (&acc)[2][2][4][2], const pg8::Unit& u, int wr, int wc, int fr, int fq) const {
        const int rowb = u.pm * 256 + wr * 64 + fr, tpb = (u.pm % 9) * 256 + wr * 64 + fr, lc = wc * 32 + 8 * fq;
#pragma unroll
        for (int bj = 0; bj < 2; ++bj) {
            const int hidx = 2 * u.pn + bj;
            if (hidx < 8) {
                const float qs = hidx < 4 ? QS_DA : 1.f; const int i0 = (lc & 63) >> 1;
#pragma unroll
                for (int ai = 0; ai < 2; ++ai)
#pragma unroll
                    for (int m = 0; m < 4; ++m) { const int ro = ai * 128 + m * 16;
                        *(u32x4_t*)(QK + (size_t)(rowb + ro) * 1024 + hidx * 128 + lc) = rope8(acc[ai][bj][m][0], acc[ai][bj][m][1], RDA + (size_t)(tpb + ro) * 32 + i0, qs); }
            } else if (hidx < 12) {
#pragma unroll
                for (int ai = 0; ai < 2; ++ai)
#pragma unroll
                    for (int m = 0; m < 4; ++m) { const int ro = ai * 128 + m * 16;
                        *(u32x4_t*)(V1 + (size_t)(rowb + ro) * 512 + (hidx - 8) * 128 + lc) = pack8(acc[ai][bj][m][0], acc[ai][bj][m][1], 1.f); }
            } else if (hidx < 17) {
                const int which = hidx >= 15 ? 1 : 0;
#pragma unroll
                for (int ai = 0; ai < 2; ++ai)
#pragma unroll
                    for (int m = 0; m < 4; ++m) { const int ro = ai * 128 + m * 16; const f32x4 a0 = acc[ai][bj][m][0], a1 = acc[ai][bj][m][1];
                        bf16_t* dst = which ? CKV + (size_t)(rowb + ro) * 256 + (hidx - 15) * 128 + lc : CQ + (size_t)(rowb + ro) * 384 + (hidx - 12) * 128 + lc;
                        *(u32x4_t*)dst = pack8(a0, a1, 1.f);
                        float ss = (a0[0] * a0[0] + a0[1] * a0[1]) + (a0[2] * a0[2] + a0[3] * a0[3]) + (a1[0] * a1[0] + a1[1] * a1[1]) + (a1[2] * a1[2] + a1[3] * a1[3]);
                        ss += __shfl_xor(ss, 16); ss += __shfl_xor(ss, 32);
                        if (fq == 0) SSQ[(size_t)(rowb + ro) * 20 + (hidx - 12) * 4 + wc] = ss; }
            } else if (hidx == 17) {
                if (wc == 0) {
#pragma unroll
                    for (int ai = 0; ai < 2; ++ai)
#pragma unroll
                        for (int m = 0; m < 4; ++m) { const int ro = ai * 128 + m * 16;
                            *(u32x4_t*)(KR + (size_t)(rowb + ro) * 32 + lc) = rope8(acc[ai][bj][m][0], acc[ai][bj][m][1], RR + (size_t)(tpb + ro) * 16 + (lc >> 1), 1.f); }
                }
            }
        }
    }
};
struct EpiMlaQ {
    static constexpr bool PERM = true, AFTER_DRAIN = false;
    bf16_t* QM; const float* SSQ; const float2* RR;
    __device__ __forceinline__ void operator()(const f32x4 (&acc)[2][2][4][2], const pg8::Unit& u, int wr, int wc, int fr, int fq) const {
        const int rowb = u.pm * 256 + wr * 64 + fr, tpb = (u.pm % 9) * 256 + wr * 64 + fr, lc = wc * 32 + 8 * fq;
#pragma unroll
        for (int ai = 0; ai < 2; ++ai)
#pragma unroll
            for (int m = 0; m < 4; ++m) { const int ro = ai * 128 + m * 16;
                const f32x4* sp = (const f32x4*)(SSQ + (size_t)(rowb + ro) * 20); const f32x4 s0 = sp[0], s1 = sp[1], s2 = sp[2];
                const float ssq = ((s0[0] + s0[1]) + (s0[2] + s0[3])) + ((s1[0] + s1[1]) + (s1[2] + s1[3])) + ((s2[0] + s2[1]) + (s2[2] + s2[3]));
                const float rs = QS_MLA * __builtin_amdgcn_rsqf(ssq * (1.f / 384.f) + EPS);
#pragma unroll
                for (int bj = 0; bj < 2; ++bj) { const int hidx = 2 * u.pn + bj;
                    bf16_t* dst = QM + (size_t)(rowb + ro) * 768 + hidx * 128 + lc;
                    if (hidx < 4) *(u32x4_t*)dst = pack8(acc[ai][bj][m][0], acc[ai][bj][m][1], rs);
                    else *(u32x4_t*)dst = rope8(acc[ai][bj][m][0], acc[ai][bj][m][1], RR + (size_t)(tpb + ro) * 16 + ((lc & 31) >> 1), rs); }
                asm volatile("" ::: "memory"); }
    }
};
struct EpiMlaKV {
    static constexpr bool PERM = true, AFTER_DRAIN = false;
    bf16_t* KVM; const float* SSQ;
    __device__ __forceinline__ void operator()(const f32x4 (&acc)[2][2][4][2], const pg8::Unit& u, int wr, int wc, int fr, int fq) const {
        const int rowb = u.pm * 256 + wr * 64 + fr, lc = wc * 32 + 8 * fq;
#pragma unroll
        for (int ai = 0; ai < 2; ++ai)
#pragma unroll
            for (int m = 0; m < 4; ++m) { const int ro = ai * 128 + m * 16;
                const f32x4* sp = (const f32x4*)(SSQ + (size_t)(rowb + ro) * 20); const f32x4 s3 = sp[3], s4 = sp[4];
                const float ssq = ((s3[0] + s3[1]) + (s3[2] + s3[3])) + ((s4[0] + s4[1]) + (s4[2] + s4[3]));
                const float rs = __builtin_amdgcn_rsqf(ssq * (1.f / 256.f) + EPS);
#pragma unroll
                for (int bj = 0; bj < 2; ++bj) *(u32x4_t*)(KVM + (size_t)(rowb + ro) * 1024 + u.pn * 256 + bj * 128 + lc) = pack8(acc[ai][bj][m][0], acc[ai][bj][m][1], rs);
                asm volatile("" ::: "memory"); }
    }
};
template <bool FROM_INPUT>
struct EpiResid2 {
    static constexpr bool PERM = true, AFTER_DRAIN = false;
    bf16_t* X; const float* MODL;
    const float* xin; const float* ctxin;
    __device__ __forceinline__ void operator()(const f32x4 (&acc)[2][2][4][2], const pg8::Unit& u, int wr, int wc, int fr, int fq) const {
        const int b = u.pm / 9, jt = u.pm - b * 9, mi = jt == 0 ? 8 : b;
        const int row0 = u.pm * 256 + wr * 64 + fr, col0 = u.pn * 256 + wc * 32 + 8 * fq;
        const float* src = FROM_INPUT ? (jt == 0 ? ctxin + (size_t)b * CTX * D : xin + ((size_t)b * SEQ + (jt - 1) * 256) * D) + (size_t)(wr * 64 + fr) * D + col0 : nullptr;
        const float* gate = MODL + mi * 6144 + 2 * 1024 + col0;
        f32x4 gv[2][2];
#pragma unroll
        for (int bj = 0; bj < 2; ++bj)
#pragma unroll
            for (int n = 0; n < 2; ++n) gv[bj][n] = *(const f32x4*)(gate + bj * 128 + n * 4);
#pragma unroll
        for (int ai = 0; ai < 2; ++ai)
#pragma unroll
            for (int m = 0; m < 4; ++m) { bf16_t* rowp = X + (size_t)(row0 + ai * 128 + m * 16) * D + col0;
                f32x4 r0[2], r1[2];
#pragma unroll
                for (int bj = 0; bj < 2; ++bj) {
                    if (FROM_INPUT) { const float* s = src + (size_t)(ai * 128 + m * 16) * D + bj * 128; r0[bj] = *(const f32x4*)s; r1[bj] = *(const f32x4*)(s + 4); }
                    else { const u32x4_t w = *(const u32x4_t*)(rowp + bj * 128);
                        r0[bj] = (f32x4){__builtin_bit_cast(float, w.x << 16), __builtin_bit_cast(float, w.x & 0xffff0000u), __builtin_bit_cast(float, w.y << 16), __builtin_bit_cast(float, w.y & 0xffff0000u)};
                        r1[bj] = (f32x4){__builtin_bit_cast(float, w.z << 16), __builtin_bit_cast(float, w.z & 0xffff0000u), __builtin_bit_cast(float, w.w << 16), __builtin_bit_cast(float, w.w & 0xffff0000u)}; } }
#pragma unroll
                for (int bj = 0; bj < 2; ++bj) *(u32x4_t*)(rowp + bj * 128) = pack8(r0[bj] + gv[bj][0] * acc[ai][bj][m][0], r1[bj] + gv[bj][1] * acc[ai][bj][m][1], 1.f); }
    }
};
struct EpiRecIn {
    static constexpr bool PERM = true, AFTER_DRAIN = false;
    bf16_t* RB; bf16_t* LF; float* GD; const float* LB1;
    __device__ __forceinline__ void operator()(const f32x4 (&acc)[2][2][4][2], const pg8::Unit& u, int wr, int wc, int fr, int fq) const {
        const int rowb = u.pm * 256 + wr * 64 + fr, lc = wc * 32 + 8 * fq;
#pragma unroll
        for (int bj = 0; bj < 2; ++bj) {
            const int hidx = 2 * u.pn + bj;
            if (hidx < 16 || (hidx >= 24 && hidx < 32)) {
                const bool act = (hidx >= 8 && hidx < 16) || hidx >= 28; const float s = hidx < 2 ? 0.125f : 1.f;
                const int dcol = (hidx < 16 ? hidx : hidx - 8) * 128 + lc;
#pragma unroll
                for (int ai = 0; ai < 2; ++ai)
#pragma unroll
                    for (int m = 0; m < 4; ++m) { const int ro = ai * 128 + m * 16; f32x4 a0 = acc[ai][bj][m][0], a1 = acc[ai][bj][m][1];
                        if (act) {
#pragma unroll
                            for (int j = 0; j < 4; ++j) { a0[j] = fast_silu(a0[j]); a1[j] = fast_silu(a1[j]); } }
                        *(u32x4_t*)(RB + (size_t)(rowb + ro) * 3072 + dcol) = pack8(a0, a1, s); }
            } else if (hidx < 24) {
                const int cp = (hidx - 16) * 128 + lc;
                const f32x4 l0 = *(const f32x4*)(LB1 + cp), l1 = *(const f32x4*)(LB1 + cp + 4);
#pragma unroll
                for (int ai = 0; ai < 2; ++ai)
#pragma unroll
                    for (int m = 0; m < 4; ++m) { const int ro = ai * 128 + m * 16; f32x4 a0 = acc[ai][bj][m][0], a1 = acc[ai][bj][m][1];
#pragma unroll
                        for (int j = 0; j < 4; ++j) {
                            const float s0 = __builtin_amdgcn_rcpf(1.f + __builtin_amdgcn_exp2f(a0[j] * -1.44269504f)), s1 = __builtin_amdgcn_rcpf(1.f + __builtin_amdgcn_exp2f(a1[j] * -1.44269504f));
                            a0[j] = __builtin_amdgcn_logf(fmaf(1.f - l0[j], s0, l0[j])) * 0.69314718f; a1[j] = __builtin_amdgcn_logf(fmaf(1.f - l1[j], s1, l1[j])) * 0.69314718f; }
                        *(u32x4_t*)(LF + (size_t)(rowb + ro) * 1024 + cp) = pack8(a0, a1, 1.f); }
            } else if (hidx == 32) {
                if (wc == 0) {
#pragma unroll
                    for (int ai = 0; ai < 2; ++ai)
#pragma unroll
                        for (int m = 0; m < 4; ++m) { const int ro = ai * 128 + m * 16; float* dst = GD + (size_t)(rowb + ro) * 32 + lc; *(f32x4*)dst = acc[ai][bj][m][0]; *(f32x4*)(dst + 4) = acc[ai][bj][m][1]; }
                }
            }
        }
    }
};

typedef float f32x16 __attribute__((ext_vector_type(16)));
typedef short bf16x8_t __attribute__((ext_vector_type(8)));
typedef __bf16 bf16x2v_t __attribute__((ext_vector_type(2)));
typedef float f32x2v_t __attribute__((ext_vector_type(2)));
__device__ __forceinline__ unsigned cvtpk_c(float lo, float hi) { const f32x2v_t v = {lo, hi}; const bf16x2v_t b = __builtin_convertvector(v, bf16x2v_t); return __builtin_bit_cast(unsigned, b); }
template <int DQK, int DV, int MODE, bool CONV = false>
__device__ __forceinline__ void attn_unit_mfma(LAS unsigned char* lds, const bf16_t* q1, const bf16_t* q2, int ldq, const bf16_t* k1, int ldk1, const bf16_t* k2, int ldk2,
                                               const bf16_t* vp, int ldv, int qrow0, int krow0, int nk, bf16_t* obf, int ldob, float lam, const float* subg, float oscale, ConvCtx* cc = nullptr) {
    constexpr int KS = DQK / 16, NDV = DV / 32, KSTR = DQK * 2 + 16, VSTR = DV * 2 + 64, KT_BYTES = 64 * KSTR, BUF = KT_BYTES + 64 * VSTR;
    constexpr int KCH = DQK / 8, VCH = DV / 8, NCH = 64 * (KCH + VCH), PER = (NCH + NT - 1) / NT;
    const int tid = threadIdx.x, wave = tid >> 6, lane = tid & 63, r = lane & 31, h = lane >> 5;
    const bf16_t* gsrc[PER]; int grs[PER]; int loff[PER];
#pragma unroll
    for (int i = 0; i < PER; ++i) { const int idx = tid + NT * i;
        if (idx < 64 * KCH) { const int row = idx / KCH, ch = idx - row * KCH;
            if (ch < 8) { gsrc[i] = k1 + (size_t)row * ldk1 + ch * 8; grs[i] = ldk1; } else { gsrc[i] = k2 + (size_t)row * ldk2 + (ch - 8) * 8; grs[i] = ldk2; }
            loff[i] = row * KSTR + ch * 16; }
        else { const int j = (idx < NCH ? idx : NCH - 1) - 64 * KCH, row = j / VCH, ch = j - row * VCH; gsrc[i] = vp + (size_t)row * ldv + ch * 8; grs[i] = ldv; loff[i] = KT_BYTES + row * VSTR + ch * 16; } }
    bf16x8_t qf[KS];
    { const size_t qrow = (size_t)qrow0 + wave * 32 + r;
#pragma unroll
      for (int ks = 0; ks < KS; ++ks) qf[ks] = *(const bf16x8_t*)(ks < 4 ? q1 + qrow * ldq + 16 * ks + 8 * h : q2 + qrow * ldq + 16 * (ks - 4) + 8 * h); }
    f32x16 ot[NDV];
#pragma unroll
    for (int d = 0; d < NDV; ++d)
#pragma unroll
        for (int i = 0; i < 16; ++i) ot[d][i] = 0.f;
    float m = -INFINITY, l = 0.f;
    u32x4_t stg[PER];
    __syncthreads();
#pragma unroll
    for (int i = 0; i < PER; ++i) stg[i] = *(const u32x4_t*)(gsrc[i] + (size_t)krow0 * grs[i]);
#pragma unroll
    for (int i = 0; i < PER; ++i) if (tid + NT * i < NCH) *(LAS u32x4_t*)(lds + loff[i]) = stg[i];
    __syncthreads();
    const int kaddr = r * KSTR + 16 * h;
    const int g = lane >> 4, q4 = (lane >> 2) & 3, p4 = lane & 3;
    const int vaddr = KT_BYTES + (4 * (g >> 1) + q4) * VSTR + (16 * (g & 1) + 4 * p4) * 2;
    ConvItem cit{}; bool cact = false; float4 cv[8];
    LAS unsigned char* cscr = lds + 61440 + __builtin_amdgcn_readfirstlane(wave) * 10240;
    for (int kt = 0; kt < nk; kt += 64) {
        const int buf = ((kt >> 6) & 1) * BUF;
        const bool more = kt + 64 < nk;
        if (more) {
#pragma unroll
            for (int i = 0; i < PER; ++i) stg[i] = *(const u32x4_t*)(gsrc[i] + (size_t)(krow0 + kt + 64) * grs[i]);
        }
        if constexpr (CONV) {
            const int ti = kt >> 6, cq = ti & 1;
            if (cact) { if (ti > 0) conv_q_stash((ti - 1) & 1, cv, cscr, lane); if (cq == 0) conv_finish(cit, cscr, lane); }
            if (cq == 0) { const int item = conv_item_index(*cc, cc->n); cact = item < conv_att_limit(*cc) && kt + 128 <= nk;
                if (cact) { cit = conv_decode_l1(*cc, item); cc->n += 1; } }
            if (cact) conv_q_issue(cit, cq, cv, lane);
        }
        f32x16 st[2];
        __builtin_amdgcn_s_setprio(1);
#pragma unroll
        for (int kb = 0; kb < 2; ++kb) {
#pragma unroll
            for (int i = 0; i < 16; ++i) st[kb][i] = 0.f;
            bf16x8_t kf[KS];
#pragma unroll
            for (int ks = 0; ks < KS; ++ks) kf[ks] = *(const LAS bf16x8_t*)(lds + buf + kb * 32 * KSTR + kaddr + 32 * ks);
            __builtin_amdgcn_sched_barrier(0);
#pragma unroll
            for (int ks = 0; ks < KS; ++ks) st[kb] = __builtin_amdgcn_mfma_f32_32x32x16_bf16(kf[ks], qf[ks], st[kb], 0, 0, 0);
        }
        __builtin_amdgcn_s_setprio(0);
        float tmax = fmaxf(st[0][0], st[1][0]);
#pragma unroll
        for (int i = 1; i < 16; ++i) tmax = fmaxf(tmax, fmaxf(st[0][i], st[1][i]));
        tmax = fmaxf(tmax, __shfl_xor(tmax, 32));
        const float mn = fmaxf(m, tmax), alpha = __builtin_amdgcn_exp2f(m - mn);
        m = mn;
        float ps = 0.f;
#pragma unroll
        for (int kb = 0; kb < 2; ++kb)
#pragma unroll
            for (int i = 0; i < 16; ++i) { const float p = __builtin_amdgcn_exp2f(st[kb][i] - mn); st[kb][i] = p; ps += p; }
        l = l * alpha + ps;
        if (!__all(alpha == 1.f)) {
#pragma unroll
            for (int d = 0; d < NDV; ++d)
#pragma unroll
                for (int i = 0; i < 16; ++i) ot[d][i] *= alpha;
        }
#pragma unroll
        for (int kb = 0; kb < 2; ++kb)
#pragma unroll
            for (int s = 0; s < 2; ++s) {
                u32x4_t pw; pw.x = cvtpk_c(st[kb][8 * s], st[kb][8 * s + 1]); pw.y = cvtpk_c(st[kb][8 * s + 2], st[kb][8 * s + 3]);
                pw.z = cvtpk_c(st[kb][8 * s + 4], st[kb][8 * s + 5]); pw.w = cvtpk_c(st[kb][8 * s + 6], st[kb][8 * s + 7]);
                const bf16x8_t pf = __builtin_bit_cast(bf16x8_t, pw);
                bf16x8_t vf[NDV];
#pragma unroll
                for (int d = 0; d < NDV; ++d) {
                    LAS unsigned char* a = lds + buf + vaddr + (kb * 32 + 16 * s) * VSTR + d * 64;
                    const v4i16_t lo = __builtin_amdgcn_ds_read_tr16_b64_v4i16((LAS v4i16_t*)a), hi = __builtin_amdgcn_ds_read_tr16_b64_v4i16((LAS v4i16_t*)(a + 8 * VSTR));
                    vf[d] = __builtin_shufflevector(lo, hi, 0, 1, 2, 3, 4, 5, 6, 7);
                }
                __builtin_amdgcn_sched_barrier(0);
#pragma unroll
                for (int d = 0; d < NDV; ++d) ot[d] = __builtin_amdgcn_mfma_f32_32x32x16_bf16(vf[d], pf, ot[d], 0, 0, 0);
            }
        if (more) {
#pragma unroll
            for (int i = 0; i < PER; ++i) if (tid + NT * i < NCH) *(LAS u32x4_t*)(lds + (BUF - buf) + loff[i]) = stg[i];
        }
        __syncthreads();
    }
    if constexpr (CONV) { if (cact) { conv_q_stash(1, cv, cscr, lane); conv_finish(cit, cscr, lane); } }
    l += __shfl_xor(l, 32);
    const float inv = 1.f / l;
    const size_t orow = (size_t)qrow0 + wave * 32 + r;
    LAS unsigned* park = (LAS unsigned*)(lds + 61440 + wave * 8192);
    if constexpr (MODE == 1) {
#pragma unroll
        for (int d = 0; d < NDV; ++d)
#pragma unroll
            for (int p = 0; p < 8; ++p) park[(d * 8 + p) * 64 + lane] = cvtpk_c(ot[d][2 * p] * inv, ot[d][2 * p + 1] * inv);
    } else if constexpr (MODE == 2) {
        float ss = 0.f;
#pragma unroll
        for (int d = 0; d < NDV; ++d)
#pragma unroll
            for (int p = 0; p < 8; ++p) { const unsigned w = park[(d * 8 + p) * 64 + lane];
                const float a = __builtin_bit_cast(float, w << 16) - lam * (ot[d][2 * p] * inv), b2 = __builtin_bit_cast(float, w & 0xffff0000u) - lam * (ot[d][2 * p + 1] * inv);
                ot[d][2 * p] = a; ot[d][2 * p + 1] = b2; ss += a * a + b2 * b2; }
        ss += __shfl_xor(ss, 32);
        const float rstd = oscale / sqrtf(ss * (1.f / DV) + EPS);
#pragma unroll
        for (int d = 0; d < NDV; ++d)
#pragma unroll
            for (int gg = 0; gg < 4; ++gg) { const int dv = d * 32 + 8 * gg + 4 * h; const f32x4 g4 = *(const f32x4*)(subg + dv);
                u32x2_t w; w.x = cvtpk_c(ot[d][4 * gg] * rstd * g4[0], ot[d][4 * gg + 1] * rstd * g4[1]); w.y = cvtpk_c(ot[d][4 * gg + 2] * rstd * g4[2], ot[d][4 * gg + 3] * rstd * g4[3]);
                *(u32x2_t*)(obf + orow * ldob + dv) = w; }
    } else {
#pragma unroll
        for (int d = 0; d < NDV; ++d)
#pragma unroll
            for (int gg = 0; gg < 4; ++gg) { const int dv = d * 32 + 8 * gg + 4 * h;
                u32x2_t w; w.x = cvtpk_c(ot[d][4 * gg] * inv, ot[d][4 * gg + 1] * inv); w.y = cvtpk_c(ot[d][4 * gg + 2] * inv, ot[d][4 * gg + 3] * inv);
                *(u32x2_t*)(obf + orow * ldob + dv) = w; }
    }
}

constexpr int SC_V_OFF = 87040, SC_SEG_OFF = 107520, SC_RED_OFF = 109568, SC_GD_OFF = 110592, SC_GK_OFF = 118784;
constexpr int SC_VSTR = 320;
template <int KIND>
struct ScanPrep {
    static constexpr int DK = KIND ? 128 : 64, CPR = DK / 8, NCHK = 64 * CPR / NT, GS = DK + 4, NSEG = NT / DK, SEGL = 64 / NSEG;
    float q[NCHK][8], k[NCHK][8];
};
__device__ __forceinline__ u32x4_t pack8f(const float* v);
template <int KIND> struct ScanRaw { f32x4 l0[ScanPrep<KIND>::NCHK], l1[ScanPrep<KIND>::NCHK]; };
template <int KIND> struct ScanQK { u32x4_t qw[ScanPrep<KIND>::NCHK], kw[ScanPrep<KIND>::NCHK]; };
template <int KIND, int LAM = 0>
__device__ __forceinline__ void scan_issue_l(ScanRaw<KIND>& R, int d, int h, size_t row0, const bf16_t* LF, const float* gkb, const bf16_t* LA = nullptr) {
    constexpr int CPR = ScanPrep<KIND>::CPR, NCHK = ScanPrep<KIND>::NCHK;
    const int tid = threadIdx.x;
#pragma unroll
    for (int n = 0; n < NCHK; ++n) { const int e = tid + NT * n, tok = e / CPR, k0 = (e - tok * CPR) * 8;
        if (KIND == 0 && LAM == 2) { R.l0[n] = __builtin_bit_cast(f32x4, *(const u32x4_t*)(LA + ((row0 + tok) * 2 + d) * 256 + h * 64 + k0)); R.l1[n] = R.l0[n]; }
        else if (KIND == 1) { R.l0[n] = __builtin_bit_cast(f32x4, *(const u32x4_t*)(LF + (row0 + tok) * 1024 + d * 512 + h * 128 + k0)); R.l1[n] = R.l0[n]; }
        else { const float* src = gkb + d * 256 + h * 64 + k0; R.l0[n] = *(const f32x4*)src; R.l1[n] = *(const f32x4*)(src + 4); } }
}
template <int KIND>
__device__ __forceinline__ void scan_issue_qk(ScanQK<KIND>& Q, int h, size_t row0, const bf16_t* RB) {
    constexpr int CPR = ScanPrep<KIND>::CPR, NCHK = ScanPrep<KIND>::NCHK;
    const int tid = threadIdx.x;
#pragma unroll
    for (int n = 0; n < NCHK; ++n) { const int e = tid + NT * n, tok = e / CPR, k0 = (e - tok * CPR) * 8; const size_t row = row0 + tok;
        if (KIND == 1) { Q.qw[n] = *(const u32x4_t*)(RB + row * 3072 + 1536 + h * 128 + k0); Q.kw[n] = Q.qw[n]; }
        else { Q.qw[n] = *(const u32x4_t*)(RB + row * 3072 + h * 64 + k0); Q.kw[n] = *(const u32x4_t*)(RB + row * 3072 + 256 + h * 64 + k0); } }
}
template <int KIND, int LAM = 0>
__device__ __forceinline__ void scan_consume(ScanPrep<KIND>& P, const ScanRaw<KIND>& R, const ScanQK<KIND>& Q, LAS unsigned char* lds, int d, bf16_t* LAw = nullptr, size_t row0 = 0, int h = 0) {
    constexpr int CPR = ScanPrep<KIND>::CPR, NCHK = ScanPrep<KIND>::NCHK, GS = ScanPrep<KIND>::GS;
    const int tid = threadIdx.x;
    LAS float* G = (LAS float*)lds;
#pragma unroll
    for (int n = 0; n < NCHK; ++n) { const int e = tid + NT * n, tok = e / CPR, k0 = (e - tok * CPR) * 8;
        float la[8];
        if (KIND == 1 || LAM == 2) { const u32x4_t lw = __builtin_bit_cast(u32x4_t, R.l0[n]);
#pragma unroll
            for (int j = 0; j < 4; ++j) { la[2 * j] = __builtin_bit_cast(float, lw[j] << 16); la[2 * j + 1] = __builtin_bit_cast(float, lw[j] & 0xffff0000u); }
        } else {
#pragma unroll
            for (int j = 0; j < 4; ++j) { la[j] = R.l0[n][j]; la[4 + j] = R.l1[n][j]; }
        }
#pragma unroll
        for (int j = 0; j < 4; ++j) { P.q[n][2 * j] = __builtin_bit_cast(float, Q.qw[n][j] << 16); P.q[n][2 * j + 1] = __builtin_bit_cast(float, Q.qw[n][j] & 0xffff0000u); }
        if (KIND == 1) {
#pragma unroll
            for (int j = 0; j < 8; ++j) P.k[n][j] = (1.f - __expf(la[j]));
        } else {
            if (LAM != 2) {
            const LAS float* gd = (const LAS float*)(lds + SC_GD_OFF) + tok * 32 + d * 16; const LAS float* gk = (const LAS float*)(lds + SC_GK_OFF) + d * 1024 + k0;
#pragma unroll 2
            for (int kk = 0; kk < 16; ++kk) { const float gv = gd[kk]; const f32x4 w0 = *(const LAS f32x4*)(gk + kk * 64), w1 = *(const LAS f32x4*)(gk + kk * 64 + 4);
#pragma unroll
                for (int j = 0; j < 4; ++j) { la[j] = fmaf(gv, w0[j], la[j]); la[4 + j] = fmaf(gv, w1[j], la[4 + j]); } }
#pragma unroll
            for (int j = 0; j < 8; ++j) la[j] = (fminf(la[j], 0.f) - __logf(1.f + __expf(-fabsf(la[j])))) * (1.f / 16.f);
            if (LAM == 1) {
                const u32x4_t lw = pack8f(la); *(u32x4_t*)(LAw + ((row0 + tok) * 2 + d) * 256 + h * 64 + k0) = lw;
#pragma unroll
                for (int j = 0; j < 4; ++j) { la[2 * j] = __builtin_bit_cast(float, lw[j] << 16); la[2 * j + 1] = __builtin_bit_cast(float, lw[j] & 0xffff0000u); } }
            }
#pragma unroll
            for (int j = 0; j < 4; ++j) { P.k[n][2 * j] = __builtin_bit_cast(float, Q.kw[n][j] << 16); P.k[n][2 * j + 1] = __builtin_bit_cast(float, Q.kw[n][j] & 0xffff0000u); }
        }
        LAS float* gp = G + tok * GS + k0; *(LAS f32x4*)gp = (f32x4){la[0], la[1], la[2], la[3]}; *(LAS f32x4*)(gp + 4) = (f32x4){la[4], la[5], la[6], la[7]};
        asm volatile("" ::: "memory");
    }
}
template <int KIND>
__device__ __forceinline__ void scan_cumsum(LAS unsigned char* lds, int d) {
    constexpr int DK = ScanPrep<KIND>::DK, GS = ScanPrep<KIND>::GS, NSEG = ScanPrep<KIND>::NSEG, SEGL = ScanPrep<KIND>::SEGL;
    const int tid = threadIdx.x, k = tid % DK, sg = tid / DK;
    LAS float* G = (LAS float*)lds; LAS float* seg = (LAS float*)(lds + SC_SEG_OFF);
    __syncthreads();
    float run = 0.f;
#pragma unroll
    for (int p = 0; p < SEGL; ++p) { const int pp = sg * SEGL + p, tok = d ? 63 - pp : pp; run += G[tok * GS + k]; G[tok * GS + k] = run; }
    seg[sg * DK + k] = run;
    __syncthreads();
    float off = 0.f;
#pragma unroll
    for (int s2 = 0; s2 < NSEG; ++s2) off += (s2 < sg) ? seg[s2 * DK + k] : 0.f;
#pragma unroll
    for (int p = 0; p < SEGL; ++p) { const int pp = sg * SEGL + p, tok = d ? 63 - pp : pp; G[tok * GS + k] += off; }
    __syncthreads();
}
__device__ __forceinline__ u32x4_t pack8f(const float* v) { u32x4_t w; w.x = cvtpk_c(v[0], v[1]); w.y = cvtpk_c(v[2], v[3]); w.z = cvtpk_c(v[4], v[5]); w.w = cvtpk_c(v[6], v[7]); return w; }
__device__ __forceinline__ void scan_load_v(LAS unsigned char* lds, const bf16_t* vsrc  , int tid) {
#pragma unroll
    for (int n = 0; n < 2; ++n) { const int e = tid + NT * n, tok = e >> 4, ch = e & 15;
        *(LAS u32x4_t*)(lds + SC_V_OFF + tok * SC_VSTR + ch * 16) = *(const u32x4_t*)(vsrc + (size_t)tok * 3072 + ch * 8); }
}
__device__ __forceinline__ void scan_load_gla(LAS unsigned char* lds, const float* GD, size_t row0, const float* gkup, int h, int tid) {
    { const int tok = tid >> 3, c4 = (tid & 7) * 4; *(LAS f32x4*)(lds + SC_GD_OFF + (tok * 32 + c4) * 4) = *(const f32x4*)(GD + (row0 + tok) * 32 + c4); }
    { const int dk = tid >> 4, c4 = (tid & 15) * 4; *(LAS f32x4*)(lds + SC_GK_OFF + (dk * 64 + c4) * 4) = *(const f32x4*)(gkup + dk * 256 + h * 64 + c4); }
}

template <int KIND>
__device__ __forceinline__ void scan_s1_unit(LAS unsigned char* lds, int b, int h, int c, const bf16_t* RB, const bf16_t* LF, const float* GD, const float* gkup, const float* gkb, unsigned* KVT, float* DEC, bf16_t* LAw) {
    constexpr int DK = ScanPrep<KIND>::DK, CPR = ScanPrep<KIND>::CPR, NCHK = ScanPrep<KIND>::NCHK, GS = ScanPrep<KIND>::GS, TSR = DK * 2 + 64, KH_OFF = 34816, NKB = DK / 32;
    const int tid = threadIdx.x, wave = tid >> 6, lane = tid & 63;
    const size_t row0 = (size_t)b * TT + (c < 4 ? 64 * c : CTX + 64 * (c - 4));
    const int chain = (b * 2 + KIND) * 4 + h, ck = b * 4 + h;
    ScanPrep<KIND> P;
    ScanRaw<KIND> Rw[2]; ScanQK<KIND> Qw; u32x4_t vr[2]; f32x4 gla0, gla1;
    scan_issue_l<KIND>(Rw[0], 0, h, row0, LF, gkb); scan_issue_qk<KIND>(Qw, h, row0, RB);
    { const bf16_t* vsrc = RB + row0 * 3072 + (KIND ? 2048 : 512) + h * 128;
#pragma unroll
      for (int n = 0; n < 2; ++n) { const int e = tid + NT * n; vr[n] = *(const u32x4_t*)(vsrc + (size_t)(e >> 4) * 3072 + (e & 15) * 8); } }
    if (KIND == 0) { gla0 = *(const f32x4*)(GD + (row0 + (tid >> 3)) * 32 + (tid & 7) * 4); gla1 = *(const f32x4*)(gkup + (tid >> 4) * 256 + h * 64 + (tid & 15) * 4); }
    scan_issue_l<KIND>(Rw[1], 1, h, row0, LF, gkb);
    __syncthreads();
#pragma unroll
    for (int n = 0; n < 2; ++n) { const int e = tid + NT * n; *(LAS u32x4_t*)(lds + SC_V_OFF + (e >> 4) * SC_VSTR + (e & 15) * 16) = vr[n]; }
    if (KIND == 0) { *(LAS f32x4*)(lds + SC_GD_OFF + ((tid >> 3) * 32 + (tid & 7) * 4) * 4) = gla0; *(LAS f32x4*)(lds + SC_GK_OFF + ((tid >> 4) * 64 + (tid & 15) * 4) * 4) = gla1; __syncthreads(); }
    LAS float* G = (LAS float*)lds;
#pragma unroll
    for (int d = 0; d < 2; ++d) {
        scan_consume<KIND, 1>(P, Rw[d], Qw, lds, d, LAw, row0, h);
        scan_cumsum<KIND>(lds, d);
        const int tl = d ? 0 : 63;
        if (tid < DK) DEC[((size_t)(chain * 2 + d) * 36 + c) * 128 + tid] = __expf(G[tl * GS + tid]);
#pragma unroll
        for (int n = 0; n < NCHK; ++n) { const int e = tid + NT * n, tok = e / CPR, k0 = (e - tok * CPR) * 8;
            float kh[8];
#pragma unroll
            for (int j = 0; j < 8; ++j) kh[j] = P.k[n][j] * __expf(G[tl * GS + k0 + j] - G[tok * GS + k0 + j]);
            *(LAS u32x4_t*)(lds + KH_OFF + tok * TSR + k0 * 2) = pack8f(kh);
            asm volatile("" ::: "memory"); }
        __syncthreads();
        const int g = lane >> 4, q4 = (lane >> 2) & 3, p4 = lane & 3, r = lane & 31, hh = lane >> 5;
        const int dvb = wave & 3;
        unsigned* out = KVT + ((size_t)(ck * 2 + d) * 36 + c) * (128 * DK / 2);
#pragma unroll
        for (int t2 = 0; t2 < NKB / 2; ++t2) { const int kb = (wave >> 2) + 2 * t2;
            f32x16 acc;
#pragma unroll
            for (int i = 0; i < 16; ++i) acc[i] = 0.f;
#pragma unroll
            for (int s = 0; s < 4; ++s) {
                LAS unsigned char* va = lds + SC_V_OFF + (16 * s + 8 * (g >> 1) + q4) * SC_VSTR + (dvb * 32 + 16 * (g & 1) + 4 * p4) * 2;
                LAS unsigned char* ka = lds + KH_OFF + (16 * s + 8 * (g >> 1) + q4) * TSR + (kb * 32 + 16 * (g & 1) + 4 * p4) * 2;
                const v4i16_t v0 = __builtin_amdgcn_ds_read_tr16_b64_v4i16((LAS v4i16_t*)va), v1 = __builtin_amdgcn_ds_read_tr16_b64_v4i16((LAS v4i16_t*)(va + 4 * SC_VSTR));
                const v4i16_t k0v = __builtin_amdgcn_ds_read_tr16_b64_v4i16((LAS v4i16_t*)ka), k1v = __builtin_amdgcn_ds_read_tr16_b64_v4i16((LAS v4i16_t*)(ka + 4 * TSR));
                acc = __builtin_amdgcn_mfma_f32_32x32x16_bf16(__builtin_shufflevector(v0, v1, 0, 1, 2, 3, 4, 5, 6, 7), __builtin_shufflevector(k0v, k1v, 0, 1, 2, 3, 4, 5, 6, 7), acc, 0, 0, 0);
            }
#pragma unroll
            for (int p = 0; p < 8; ++p) out[((dvb * NKB + kb) * 8 + p) * 64 + lane] = cvtpk_c(acc[2 * p], acc[2 * p + 1]);
        }
    }
}

__device__ __forceinline__ void scan_s2(const unsigned* KVT0, const unsigned* KVT1, const float* DEC, bf16_t* SST0, bf16_t* SST1, int bid, int nb) {
    const size_t gtid = (size_t)bid * NT + threadIdx.x, gth = (size_t)nb * NT;
    constexpr size_t N0 = (size_t)32 * 2 * 1024, N1 = (size_t)32 * 2 * 2048;
    for (size_t it = gtid; it < N0 + N1; it += gth) {
        size_t r = it; int kind, DKk; const unsigned* KVT; bf16_t* SST;
        if (r < N0) { kind = 0; DKk = 64; KVT = KVT0; SST = SST0; } else { r -= N0; kind = 1; DKk = 128; KVT = KVT1; SST = SST1; }
        const int nv = 128 * DKk / 8, NKB = DKk / 32; const int cd = (int)(r / nv), v = (int)(r - (size_t)cd * nv); const int ck = cd >> 1, d = cd & 1;
        const int b = ck >> 2, h = ck & 3, chain = (b * 2 + kind) * 4 + h;
        const int t = v >> 7, rem = v & 127, p = rem >> 4, lg = rem & 15, hh = lg >> 3, dvb = t / NKB, kb = t - dvb * NKB;
        const int k0 = kb * 32 + ((4 * lg) & 31), dva = dvb * 32 + ((2 * p) & 3) + 8 * ((2 * p) >> 2) + 4 * hh;
        const unsigned* kv = KVT + ((size_t)(ck * 2 + d) * 36) * (128 * DKk / 2) + (t * 8 + p) * 64 + 4 * lg;
        const float* dc = DEC + ((size_t)(chain * 2 + d) * 36) * 128 + k0;
        bf16_t* ss = SST + ((size_t)(ck * 2 + d) * 32) * (128 * DKk) + (size_t)dva * DKk + k0;
        f32x4 Sa = {0.f, 0.f, 0.f, 0.f}, Sb = {0.f, 0.f, 0.f, 0.f};
#pragma unroll 1
        for (int g0 = 0; g0 < 36; g0 += 12) {
            f32x4 av[12]; u32x4_t uv[12];
#pragma unroll
            for (int j = 0; j < 12; ++j) { const int step = g0 + j, c = d ? (step < 4 ? 3 - step : 4 + (35 - step)) : step;
                av[j] = *(const f32x4*)(dc + (size_t)c * 128); uv[j] = *(const u32x4_t*)(kv + (size_t)c * (128 * DKk / 2)); }
#pragma unroll
            for (int j = 0; j < 12; ++j) { const int step = g0 + j, c = d ? (step < 4 ? 3 - step : 4 + (35 - step)) : step;
                if (c >= 4) { bf16_t* o = ss + (size_t)(c - 4) * (128 * DKk);
                    u32x2_t w; w.x = cvtpk_c(Sa[0], Sa[1]); w.y = cvtpk_c(Sa[2], Sa[3]); *(u32x2_t*)o = w;
                    w.x = cvtpk_c(Sb[0], Sb[1]); w.y = cvtpk_c(Sb[2], Sb[3]); *(u32x2_t*)(o + DKk) = w; }
                const u32x4_t u = uv[j];
                const f32x4 ua = {__builtin_bit_cast(float, u[0] << 16), __builtin_bit_cast(float, u[1] << 16), __builtin_bit_cast(float, u[2] << 16), __builtin_bit_cast(float, u[3] << 16)};
                const f32x4 ub = {__builtin_bit_cast(float, u[0] & 0xffff0000u), __builtin_bit_cast(float, u[1] & 0xffff0000u), __builtin_bit_cast(float, u[2] & 0xffff0000u), __builtin_bit_cast(float, u[3] & 0xffff0000u)};
                Sa = av[j] * Sa + ua; Sb = av[j] * Sb + ub; }
        }
    }
}

template <int KIND>
__device__ __forceinline__ void scan_s3_unit(LAS unsigned char* lds, int b, int h, int lc, const bf16_t* RB, const bf16_t* LF, const float* GD, const float* gkup, const float* gkb,
                                             const bf16_t* SST, const float* gn, bf16_t* R, const bf16_t* LA) {
    constexpr int DK = ScanPrep<KIND>::DK, CPR = ScanPrep<KIND>::CPR, NCHK = ScanPrep<KIND>::NCHK, GS = ScanPrep<KIND>::GS, KS = DK / 16, TS = DK * 2 + 16;
    constexpr int QT_OFF = 34816, KT_OFF = QT_OFF + 64 * 272, QH_OFF = KT_OFF + 64 * 272;
    const int tid = threadIdx.x, wave = tid >> 6, lane = tid & 63;
    const size_t row0 = (size_t)b * TT + CTX + 64 * lc;
    const int ck = b * 4 + h;
    ScanPrep<KIND> P;
    const int g = lane >> 4, q4 = (lane >> 2) & 3, p4 = lane & 3, r = lane & 31, hh = lane >> 5, dvb = wave & 3, ib = wave >> 2;
    ScanRaw<KIND> Rw[2]; ScanQK<KIND> Qw; bf16x8_t sfs[2][KS]; u32x4_t vr[2]; u32x2_t gwr[4];
    scan_issue_l<KIND, 2>(Rw[0], 0, h, row0, LF, gkb, LA); scan_issue_qk<KIND>(Qw, h, row0, RB);
    { const bf16_t* vsrc = RB + row0 * 3072 + (KIND ? 2048 : 512) + h * 128;
#pragma unroll
      for (int n = 0; n < 2; ++n) { const int e = tid + NT * n; vr[n] = *(const u32x4_t*)(vsrc + (size_t)(e >> 4) * 3072 + (e & 15) * 8); } }
#pragma unroll
    for (int d = 0; d < 2; ++d) { const bf16_t* sp = SST + ((size_t)(ck * 2 + d) * 32 + lc) * (128 * DK) + (size_t)(dvb * 32 + r) * DK + 8 * hh;
#pragma unroll
        for (int ks = 0; ks < KS; ++ks) sfs[d][ks] = *(const bf16x8_t*)(sp + 16 * ks); }
    scan_issue_l<KIND, 2>(Rw[1], 1, h, row0, LF, gkb, LA);
#pragma unroll
    for (int gg = 0; gg < 4; ++gg) gwr[gg] = *(const u32x2_t*)(RB + (row0 + ib * 32 + r) * 3072 + (KIND ? 2560 : 1024) + h * 128 + dvb * 32 + 8 * gg + 4 * hh);
    __syncthreads();
#pragma unroll
    for (int n = 0; n < 2; ++n) { const int e = tid + NT * n; *(LAS u32x4_t*)(lds + SC_V_OFF + (e >> 4) * SC_VSTR + (e & 15) * 16) = vr[n]; }
    LAS float* G = (LAS float*)lds;
    f32x16 ot;
#pragma unroll
    for (int i = 0; i < 16; ++i) ot[i] = 0.f;
#pragma unroll
    for (int d = 0; d < 2; ++d) {
        scan_consume<KIND, 2>(P, Rw[d], Qw, lds, d);
        scan_cumsum<KIND>(lds, d);
#pragma unroll
        for (int n = 0; n < NCHK; ++n) { const int e = tid + NT * n, tok = e / CPR, k0 = (e - tok * CPR) * 8;
            float qt[8], kt[8], qh[8];
#pragma unroll
            for (int j = 0; j < 8; ++j) { const float gi = G[tok * GS + k0 + j], gr = G[32 * GS + k0 + j]; const float eq = __expf(gi - gr);
                qt[j] = P.q[n][j] * eq; kt[j] = P.k[n][j] * __expf(gr - gi); qh[j] = P.q[n][j] * __expf(gi); }
            *(LAS u32x4_t*)(lds + QT_OFF + tok * TS + k0 * 2) = pack8f(qt); *(LAS u32x4_t*)(lds + KT_OFF + tok * TS + k0 * 2) = pack8f(kt); *(LAS u32x4_t*)(lds + QH_OFF + tok * TS + k0 * 2) = pack8f(qh);
            asm volatile("" ::: "memory"); }
        __syncthreads();
#pragma unroll
        for (int ks = 0; ks < KS; ++ks) { const bf16x8_t qf = *(const LAS bf16x8_t*)(lds + QH_OFF + (ib * 32 + r) * TS + 32 * ks + 16 * hh);
            ot = __builtin_amdgcn_mfma_f32_32x32x16_bf16(sfs[d][ks], qf, ot, 0, 0, 0); }
#pragma unroll
        for (int jb = 0; jb < 2; ++jb) {
            if (d == 0 ? (jb > ib) : (jb < ib)) continue;
            f32x16 st;
#pragma unroll
            for (int i = 0; i < 16; ++i) st[i] = 0.f;
#pragma unroll
            for (int ks = 0; ks < KS; ++ks) { const bf16x8_t kf = *(const LAS bf16x8_t*)(lds + KT_OFF + (jb * 32 + r) * TS + 32 * ks + 16 * hh), qf = *(const LAS bf16x8_t*)(lds + QT_OFF + (ib * 32 + r) * TS + 32 * ks + 16 * hh);
                st = __builtin_amdgcn_mfma_f32_32x32x16_bf16(kf, qf, st, 0, 0, 0); }
            if (jb == ib) {
#pragma unroll
                for (int i = 0; i < 16; ++i) { const int jl = (i & 3) + 8 * (i >> 2) + 4 * hh; const bool keep = d == 0 ? (jl <= r) : (jl >= r); st[i] = keep ? st[i] : 0.f; }
            }
#pragma unroll
            for (int s = 0; s < 2; ++s) {
                u32x4_t pw; pw.x = cvtpk_c(st[8 * s], st[8 * s + 1]); pw.y = cvtpk_c(st[8 * s + 2], st[8 * s + 3]); pw.z = cvtpk_c(st[8 * s + 4], st[8 * s + 5]); pw.w = cvtpk_c(st[8 * s + 6], st[8 * s + 7]);
                LAS unsigned char* va = lds + SC_V_OFF + (jb * 32 + 16 * s + 4 * (g >> 1) + q4) * SC_VSTR + (dvb * 32 + 16 * (g & 1) + 4 * p4) * 2;
                const v4i16_t v0 = __builtin_amdgcn_ds_read_tr16_b64_v4i16((LAS v4i16_t*)va), v1 = __builtin_amdgcn_ds_read_tr16_b64_v4i16((LAS v4i16_t*)(va + 8 * SC_VSTR));
                ot = __builtin_amdgcn_mfma_f32_32x32x16_bf16(__builtin_shufflevector(v0, v1, 0, 1, 2, 3, 4, 5, 6, 7), __builtin_bit_cast(bf16x8_t, pw), ot, 0, 0, 0);
            }
        }
    }
    float ss = 0.f;
#pragma unroll
    for (int i = 0; i < 16; ++i) ss += ot[i] * ot[i];
    ss += __shfl_xor(ss, 32);
    LAS float* red = (LAS float*)(lds + SC_RED_OFF);
    if (hh == 0) red[wave * 32 + r] = ss;
    __syncthreads();
    const float tot = red[(ib * 4 + 0) * 32 + r] + red[(ib * 4 + 1) * 32 + r] + red[(ib * 4 + 2) * 32 + r] + red[(ib * 4 + 3) * 32 + r];
    const float rstd = 1.f / sqrtf(tot * (1.f / 128.f) + EPS);
    const size_t row = row0 + ib * 32 + r;
#pragma unroll
    for (int gg = 0; gg < 4; ++gg) { const int dv = dvb * 32 + 8 * gg + 4 * hh;
        const f32x4 gv = *(const f32x4*)(gn + dv);
        const u32x2_t gw = gwr[gg];
        const float g0 = __builtin_bit_cast(float, gw.x << 16), g1 = __builtin_bit_cast(float, gw.x & 0xffff0000u), g2 = __builtin_bit_cast(float, gw.y << 16), g3 = __builtin_bit_cast(float, gw.y & 0xffff0000u);
        u32x2_t w; w.x = cvtpk_c(ot[4 * gg] * rstd * gv[0] * g0, ot[4 * gg + 1] * rstd * gv[1] * g1); w.y = cvtpk_c(ot[4 * gg + 2] * rstd * gv[2] * g2, ot[4 * gg + 3] * rstd * gv[3] * g3);
        *(u32x2_t*)(R + row * D + KIND * 512 + h * 128 + dv) = w; }
}

struct Args { const float* in[31]; float* out; unsigned char* ws; int ph_lo, ph_hi; };
enum { I_X = 0, I_C, I_CTX, I_CCTX, I_ADAW, I_ADAB, I_N1G, I_N2G, I_ATTWIN, I_QNG, I_QUP, I_KVNG, I_KVUP, I_LQ1, I_LK1, I_LQ2, I_LK2, I_SUBLN, I_ATTWOUT,
       I_RECWIN, I_GKUP, I_GKB, I_GLANG, I_LBL, I_HGNG, I_RECWOUT, I_ROUTER, I_WG, I_WU, I_WD, I_FNG };
constexpr int N_PHASES = 26;

__device__ __forceinline__ void phase_norm1(const float* xin, const float* ctxin, bf16_t* H, const float* g, const float* MODL, int bid, int nb) {
    const int tid = threadIdx.x, lane = tid & 63, wave = tid >> 6, stride = nb * NWAVES;
    for (int ra = bid * NWAVES + wave; ra < MT; ra += 2 * stride) {
        const int rb = ra + stride; const bool hasb = rb < MT;
        float4 v[2][4];
#pragma unroll
        for (int q = 0; q < 2; ++q) { const int r = q ? (hasb ? rb : ra) : ra; const int b0 = r / TT, t0 = r - b0 * TT;
            const float4* xr = (const float4*)(t0 < CTX ? ctxin + ((size_t)b0 * CTX + t0) * D : xin + ((size_t)b0 * SEQ + (t0 - CTX)) * D) + lane;
#pragma unroll
            for (int j = 0; j < 4; ++j) v[q][j] = xr[64 * j]; }
#pragma unroll
        for (int q = 0; q < 2; ++q) {
            if (q == 1 && !hasb) break;
            const int r = q ? rb : ra;
            float ss = 0.f;
#pragma unroll
            for (int j = 0; j < 4; ++j) ss += v[q][j].x * v[q][j].x + v[q][j].y * v[q][j].y + v[q][j].z * v[q][j].z + v[q][j].w * v[q][j].w;
            ss = wave_sum(ss);
            const float rstd = 1.f / sqrtf(ss * (1.f / D) + EPS);
            const int mi = mod_index(r);
            const float* sh = MODL + mi * 6144; const float* sc = sh + 1024;
#pragma unroll
            for (int j = 0; j < 4; ++j) {
                const int c = (lane + 64 * j) * 4;
                const float4 g4 = *(const float4*)(g + c), s4 = *(const float4*)(sh + c), c4 = *(const float4*)(sc + c);
                u32x2_t w; w.x = pk_bf16(v[q][j].x * rstd * g4.x * (1.f + c4.x) + s4.x, v[q][j].y * rstd * g4.y * (1.f + c4.y) + s4.y);
                w.y = pk_bf16(v[q][j].z * rstd * g4.z * (1.f + c4.z) + s4.z, v[q][j].w * rstd * g4.w * (1.f + c4.w) + s4.w);
                *((u32x2_t*)(H + (size_t)r * D) + lane + 64 * j) = w;
            }
        }
    }
}
template <int N, int O>
__device__ __forceinline__ void rs_step(float* v, int lane) {
    const bool up = (lane & O) != 0;
#pragma unroll
    for (int i = 0; i < N / 2; ++i) { const float send = up ? v[i] : v[N / 2 + i], keep = up ? v[N / 2 + i] : v[i]; v[i] = keep + __shfl_xor(send, O); }
}
__device__ __forceinline__ void phase_norm2_router(LAS unsigned char* ldsb, bf16_t* X, unsigned char* H8p, const float* g, const float* MODL, const float* wr, float* AFF, int* SEL, int bid, int nb, bool latent_only, const bf16_t* CP, const float* ctxin) {
    const int tid = threadIdx.x, lane = tid & 63, wave = tid >> 6;
    LAS f32x4* W2 = (LAS f32x4*)ldsb;
    LAS float* lg = (LAS float*)(ldsb + 65536) + wave * 64;
    __syncthreads();
    for (int idx = tid; idx < 4096; idx += NT) { const int c = idx >> 2, e4 = idx & 3, ln = (c >> 2) & 63, j = c >> 8, q = c & 3;
        W2[((j * 4 + q) * 4 + e4) * 64 + ln] = *(const f32x4*)(wr + (size_t)c * 16 + e4 * 4); }
    __syncthreads();
    if (CP != nullptr) {
#pragma unroll 1
        for (int r0 = (bid * NWAVES + wave) * 3; r0 < MT; r0 += nb * NWAVES * 3) {
            if ((r0 % TT) >= CTX) continue;
#pragma unroll 1
            for (int rr = 0; rr < 3; ++rr) { const int r = r0 + rr, bq = r / TT, tq = r - bq * TT;
                if (tq >= CTX) continue;
                u32x2_t pw[4][4]; float4 in4[4];
#pragma unroll
                for (int s = 0; s < 4; ++s)
#pragma unroll
                    for (int j = 0; j < 4; ++j) pw[s][j] = *((const u32x2_t*)(CP + (((size_t)s * NB + bq) * 256 + tq) * D) + lane + 64 * j);
#pragma unroll
                for (int j = 0; j < 4; ++j) in4[j] = *((const float4*)(ctxin + ((size_t)bq * CTX + tq) * D) + lane + 64 * j);
#pragma unroll
                for (int j = 0; j < 4; ++j) { const float4 g4 = *((const float4*)(MODL + 8 * 6144 + 2 * 1024) + lane + 64 * j);
                    float4 a = make_float4(0.f, 0.f, 0.f, 0.f);
#pragma unroll
                    for (int s = 0; s < 4; ++s) { a.x += __builtin_bit_cast(float, pw[s][j].x << 16); a.y += __builtin_bit_cast(float, pw[s][j].x & 0xffff0000u); a.z += __builtin_bit_cast(float, pw[s][j].y << 16); a.w += __builtin_bit_cast(float, pw[s][j].y & 0xffff0000u); }
                    u32x2_t w; w.x = pk_bf16(in4[j].x + g4.x * a.x, in4[j].y + g4.y * a.y); w.y = pk_bf16(in4[j].z + g4.z * a.z, in4[j].w + g4.w * a.w);
                    *((u32x2_t*)(X + (size_t)r * D) + lane + 64 * j) = w; } }
        }
        asm volatile("s_waitcnt vmcnt(0)" ::: "memory");
    }
    for (int r0 = (bid * NWAVES + wave) * 3; r0 < MT; r0 += nb * NWAVES * 3) {
        if (latent_only && (r0 % TT) + 2 < CTX) continue;
        float hv[3][16];
#pragma unroll
        for (int rr = 0; rr < 3; ++rr) {
            const int r = r0 + rr;
            u32x2_t* xr = (u32x2_t*)(X + (size_t)r * D) + lane;
            float4 v[4]; float ss = 0.f;
            { u32x2_t xw[4];
#pragma unroll
              for (int j = 0; j < 4; ++j) xw[j] = xr[64 * j];
#pragma unroll
              for (int j = 0; j < 4; ++j) v[j] = make_float4(__builtin_bit_cast(float, xw[j].x << 16), __builtin_bit_cast(float, xw[j].x & 0xffff0000u), __builtin_bit_cast(float, xw[j].y << 16), __builtin_bit_cast(float, xw[j].y & 0xffff0000u)); }
#pragma unroll
            for (int j = 0; j < 4; ++j) ss += v[j].x * v[j].x + v[j].y * v[j].y + v[j].z * v[j].z + v[j].w * v[j].w;
            ss = wave_sum(ss);
            const float rstd = 1.f / sqrtf(ss * (1.f / D) + EPS);
            const int mi = mod_index(r);
            const float* sh = MODL + mi * 6144 + 3 * 1024; const float* sc = sh + 1024;
#pragma unroll
            for (int j = 0; j < 4; ++j) {
                const int c = (lane + 64 * j) * 4;
                const float4 g4 = *(const float4*)(g + c), s4 = *(const float4*)(sh + c), c4 = *(const float4*)(sc + c);
                hv[rr][4 * j + 0] = v[j].x * rstd * g4.x * (1.f + c4.x) + s4.x; hv[rr][4 * j + 1] = v[j].y * rstd * g4.y * (1.f + c4.y) + s4.y;
                hv[rr][4 * j + 2] = v[j].z * rstd * g4.z * (1.f + c4.z) + s4.z; hv[rr][4 * j + 3] = v[j].w * rstd * g4.w * (1.f + c4.w) + s4.w;
                *((unsigned*)(H8p + (size_t)r * D) + lane + 64 * j) = pk4_fp8(hv[rr][4 * j], hv[rr][4 * j + 1], hv[rr][4 * j + 2], hv[rr][4 * j + 3]);
            }
            asm volatile("" ::: "memory");
        }
        float p[48];
#pragma unroll
        for (int i = 0; i < 48; ++i) p[i] = 0.f;
#pragma unroll
        for (int jq = 0; jq < 16; ++jq)
#pragma unroll
            for (int e4 = 0; e4 < 4; ++e4) { const f32x4 w = W2[(jq * 4 + e4) * 64 + lane];
#pragma unroll
                for (int rr = 0; rr < 3; ++rr)
#pragma unroll
                    for (int t = 0; t < 4; ++t) p[rr * 16 + e4 * 4 + t] = fmaf(hv[rr][jq], w[t], p[rr * 16 + e4 * 4 + t]); }
        rs_step<48, 32>(p, lane); rs_step<24, 16>(p, lane); rs_step<12, 8>(p, lane); rs_step<6, 4>(p, lane);
#pragma unroll
        for (int i = 0; i < 3; ++i) { p[i] += __shfl_xor(p[i], 2); p[i] += __shfl_xor(p[i], 1); }
        const int base = ((lane & 32) ? 24 : 0) + ((lane & 16) ? 12 : 0) + ((lane & 8) ? 6 : 0) + ((lane & 4) ? 3 : 0);
        if ((lane & 3) == 0) { lg[base] = p[0]; lg[base + 1] = p[1]; lg[base + 2] = p[2]; }
        asm volatile("s_waitcnt lgkmcnt(0)" ::: "memory");
        float x = lane < 48 ? lg[lane] : 0.f;
        float mx = x;
        mx = fmaxf(mx, __shfl_xor(mx, 1)); mx = fmaxf(mx, __shfl_xor(mx, 2)); mx = fmaxf(mx, __shfl_xor(mx, 4)); mx = fmaxf(mx, __shfl_xor(mx, 8));
        const float ex = expf(x - mx);
        float den = ex;
        den += __shfl_xor(den, 1); den += __shfl_xor(den, 2); den += __shfl_xor(den, 4); den += __shfl_xor(den, 8);
        if (lane < 48) { const size_t o = (size_t)(r0 + (lane >> 4)) * 16 + (lane & 15); AFF[o] = ex / den; SEL[o] = -1; }
        asm volatile("s_waitcnt lgkmcnt(0)" ::: "memory");
    }
}

__device__ __forceinline__ int block_excl_scan(int v, int& total, volatile LAS int* wsum, int tid) {
    const int lane = tid & 63, wave = tid >> 6;
    int inc = v;
#pragma unroll
    for (int o = 1; o < 64; o <<= 1) { const int t = __shfl_up(inc, o); if (lane >= o) inc += t; }
    __syncthreads();
    if (lane == 63) wsum[wave] = inc;
    __syncthreads();
    int off = 0, tot = 0;
#pragma unroll
    for (int w = 0; w < NWAVES; ++w) { const int s = wsum[w]; tot += s; off += (w < wave) ? s : 0; }
    total = tot;
    return off + inc - v;
}
__device__ __forceinline__ void phase_topk(LAS unsigned char* ldsb, const float* AFF, int* SEL, int* AROW, float* GATE, bool with_ctx, int bid, int nb) {
    const int tid = threadIdx.x;
    volatile LAS int* hist = (volatile LAS int*)ldsb;
    volatile LAS int* wsum = hist + 256;
    volatile LAS unsigned* ctl = (volatile LAS unsigned*)(hist + 272);
    const int nunits = with_ctx ? 256 : 128;
    for (int u = bid; u < nunits; u += nb) {
        const int kind = u >> 7, b = (u >> 4) & 7, e = u & 15;
        const int n = kind ? CTX : SEQ, cap = kind ? 32 : 256, row0 = b * TT + (kind ? 0 : CTX);
        unsigned key[4];
#pragma unroll
        for (int j = 0; j < 4; ++j) { const int i = 4 * tid + j; key[j] = i < n ? __builtin_bit_cast(unsigned, AFF[(size_t)(row0 + i) * 16 + e]) : 0u; }
        unsigned prefix = 0u; int need = cap;
#pragma unroll 1
        for (int pass = 3; pass >= 0; --pass) {
            __syncthreads();
            if (tid < 256) hist[tid] = 0;
            __syncthreads();
            const int sh = 8 * pass;
#pragma unroll
            for (int j = 0; j < 4; ++j) { const bool match = (pass == 3) ? (key[j] != 0u) : ((key[j] >> (sh + 8)) == (prefix >> (sh + 8)) && key[j] != 0u);
                if (match) (void)__hip_atomic_fetch_add((LAS int*)&hist[(key[j] >> sh) & 255u], 1, __ATOMIC_RELAXED, __HIP_MEMORY_SCOPE_WORKGROUP); }
            __syncthreads();
            if (tid < 64) {
                const int h0 = hist[4 * tid], h1 = hist[4 * tid + 1], h2 = hist[4 * tid + 2], h3 = hist[4 * tid + 3];
                const int mine = h0 + h1 + h2 + h3;
                int inc = mine;
#pragma unroll
                for (int o = 1; o < 64; o <<= 1) { const int t = __shfl_down(inc, o); if (tid + o < 64) inc += t; }
                const int above = inc - mine;
                if (above < need && need <= inc) {
                    int dg, ab = above;
                    if (ab + h3 >= need) dg = 3; else { ab += h3; if (ab + h2 >= need) dg = 2; else { ab += h2; if (ab + h1 >= need) dg = 1; else { ab += h1; dg = 0; } } }
                    ctl[0] = prefix | ((unsigned)(4 * tid + dg) << sh); ctl[1] = (unsigned)(need - ab);
                }
            }
            __syncthreads();
            prefix = ctl[0]; need = (int)ctl[1];
        }
        int eqc = 0;
#pragma unroll
        for (int j = 0; j < 4; ++j) eqc += (key[j] == prefix) ? 1 : 0;
        int tot;
        int eqpos = block_excl_scan(eqc, tot, wsum, tid);
        int selc = 0; bool sel[4];
#pragma unroll
        for (int j = 0; j < 4; ++j) { const bool eq = key[j] == prefix; sel[j] = key[j] > prefix || (eq && eqpos < need); eqpos += eq ? 1 : 0; selc += sel[j] ? 1 : 0; }
        int slot = block_excl_scan(selc, tot, wsum, tid);
#pragma unroll
        for (int j = 0; j < 4; ++j) if (sel[j]) { const int i = 4 * tid + j, m = kind ? 2048 + b * 32 + slot : b * 256 + slot; ++slot;
            AROW[e * MEXP + m] = row0 + i; GATE[e * MEXP + m] = __builtin_bit_cast(float, key[j]); SEL[(size_t)(row0 + i) * 16 + e] = m; }
    }
}

__device__ __forceinline__ void phase_combine(bf16_t* X, const bf16_t* Y, const bf16_t* Y2p, const int* SEL, int mrows, const float* MODL, bool latent_only, const float* fng, float* out, bf16_t* Hn, const float* gn1, const float* MODN, int bid, int nb) {
    const int tid = threadIdx.x, lane = tid & 63, wave = tid >> 6;
    for (int r = bid * NWAVES + wave; r < MT; r += nb * NWAVES) {
        const int b = r / TT, tp = r - b * TT;
        if (latent_only && tp < CTX) continue;
        float4 acc[4];
#pragma unroll
        for (int j = 0; j < 4; ++j) acc[j] = make_float4(0.f, 0.f, 0.f, 0.f);
        int msel[16];
        { const int4* sp = (const int4*)(SEL + (size_t)r * 16);
#pragma unroll
          for (int q = 0; q < 4; ++q) { const int4 s4 = sp[q]; msel[4 * q] = __builtin_amdgcn_readfirstlane(s4.x); msel[4 * q + 1] = __builtin_amdgcn_readfirstlane(s4.y); msel[4 * q + 2] = __builtin_amdgcn_readfirstlane(s4.z); msel[4 * q + 3] = __builtin_amdgcn_readfirstlane(s4.w); } }
        u32x2_t yv[16][4];
#pragma unroll
        for (int e = 0; e < 16; ++e) {
#pragma unroll
            for (int j = 0; j < 4; ++j) yv[e][j] = (u32x2_t){0u, 0u};
            const int m = msel[e];
            if (m >= 0) {
                if (Y2p != nullptr && m >= 2048) {
                    float4 t4[4];
#pragma unroll
                    for (int j = 0; j < 4; ++j) t4[j] = make_float4(0.f, 0.f, 0.f, 0.f);
                    for (int s = 0; s < 4; ++s) { const u32x2_t* y = (const u32x2_t*)(Y2p + (((size_t)s * NE + e) * 256 + (m - 2048)) * D) + lane;
#pragma unroll
                        for (int j = 0; j < 4; ++j) { const u32x2_t w = y[64 * j];
                            t4[j].x += __builtin_bit_cast(float, w.x << 16); t4[j].y += __builtin_bit_cast(float, w.x & 0xffff0000u); t4[j].z += __builtin_bit_cast(float, w.y << 16); t4[j].w += __builtin_bit_cast(float, w.y & 0xffff0000u); } }
#pragma unroll
                    for (int j = 0; j < 4; ++j) { acc[j].x += t4[j].x; acc[j].y += t4[j].y; acc[j].z += t4[j].z; acc[j].w += t4[j].w; }
                } else {
                    const u32x2_t* y = (const u32x2_t*)(Y + ((size_t)e * mrows + m) * D) + lane;
#pragma unroll
                    for (int j = 0; j < 4; ++j) yv[e][j] = y[64 * j];
                }
            }
        }
#pragma unroll
        for (int e = 0; e < 16; ++e)
#pragma unroll
            for (int j = 0; j < 4; ++j) { const u32x2_t w = yv[e][j];
                acc[j].x += __builtin_bit_cast(float, w.x << 16); acc[j].y += __builtin_bit_cast(float, w.x & 0xffff0000u); acc[j].z += __builtin_bit_cast(float, w.y << 16); acc[j].w += __builtin_bit_cast(float, w.y & 0xffff0000u); }
        const float* gm = MODL + mod_index(r) * 6144 + 5 * 1024;
        u32x2_t* xr = (u32x2_t*)(X + (size_t)r * D) + lane;
        u32x2_t xw[4]; float4 xv[4]; float ss = 0.f;
#pragma unroll
        for (int j = 0; j < 4; ++j) xw[j] = xr[64 * j];
#pragma unroll
        for (int j = 0; j < 4; ++j) { const float4 g4 = *((const float4*)gm + lane + 64 * j);
            float4 x = make_float4(__builtin_bit_cast(float, xw[j].x << 16), __builtin_bit_cast(float, xw[j].x & 0xffff0000u), __builtin_bit_cast(float, xw[j].y << 16), __builtin_bit_cast(float, xw[j].y & 0xffff0000u));
            x.x += g4.x * acc[j].x; x.y += g4.y * acc[j].y; x.z += g4.z * acc[j].z; x.w += g4.w * acc[j].w; xv[j] = x;
            if (!out) { u32x2_t w; w.x = pk_bf16(x.x, x.y); w.y = pk_bf16(x.z, x.w); xr[64 * j] = w; }
            ss += x.x * x.x + x.y * x.y + x.z * x.z + x.w * x.w; }
        if (Hn) {
            ss = wave_sum(ss); const float rstd = 1.f / sqrtf(ss * (1.f / D) + EPS);
            const float* sh = MODN + mod_index(r) * 6144; const float* sc = sh + 1024;
#pragma unroll
            for (int j = 0; j < 4; ++j) { const int c = (lane + 64 * j) * 4;
                const float4 g4 = *(const float4*)(gn1 + c), s4 = *(const float4*)(sh + c), c4 = *(const float4*)(sc + c);
                u32x2_t w; w.x = pk_bf16(xv[j].x * rstd * g4.x * (1.f + c4.x) + s4.x, xv[j].y * rstd * g4.y * (1.f + c4.y) + s4.y);
                w.y = pk_bf16(xv[j].z * rstd * g4.z * (1.f + c4.z) + s4.z, xv[j].w * rstd * g4.w * (1.f + c4.w) + s4.w);
                *((u32x2_t*)(Hn + (size_t)r * D) + lane + 64 * j) = w; }
        }
        if (out) {
            ss = wave_sum(ss); const float rstd = 1.f / sqrtf(ss * (1.f / D) + EPS);
            float4* orow = (float4*)(out + ((size_t)b * SEQ + (tp - CTX)) * D) + lane;
#pragma unroll
            for (int j = 0; j < 4; ++j) { const float4 g4 = *((const float4*)fng + lane + 64 * j); float4 o; o.x = xv[j].x * rstd * g4.x; o.y = xv[j].y * rstd * g4.y; o.z = xv[j].z * rstd * g4.z; o.w = xv[j].w * rstd * g4.w; orow[64 * j] = o; }
        }
    }
}

__device__ __forceinline__ void phase_moe_up(LAS unsigned char* lds, const unsigned char* H8p, const int* AROWp, const unsigned char* WGU8p, unsigned char* HID8p, int mrows, int bid, int nb) {
    const int nMe = mrows / 256;
    pg8::Gemm g{(const bf16_t*)H8p, (const bf16_t*)WGU8p, NE * mrows, NE * 5632, D / 2};
    OrderShareB S{nMe, 22, NE * 22, nb, bid, AROWp};
    EpiSwiGLU E{HID8p, nMe};
    pg8::gemm_phase<EpiSwiGLU, OrderShareB, true, true, true, false, true>(lds, g, S, E);
}
__device__ __forceinline__ void phase_moe_down(LAS unsigned char* lds, const unsigned char* HID8p, const unsigned char* WDT8p, bf16_t* YFp, bf16_t* Y2p, const float* GATE, int mrows, int bid, int nb) {
    const int nMe = mrows / 256;
    pg8::Gemm g{(const bf16_t*)HID8p, (const bf16_t*)WDT8p, NE * mrows, NE * D, FF / 2};
    if (Y2p == nullptr) {
        OrderShareA S{nMe, 4, NE * nMe, nb, bid, nMe};
        EpiDownGate E{YFp, GATE, nMe};
        pg8::gemm_phase<EpiDownGate, OrderShareA, true, true, false, false, true>(lds, g, S, E);
    } else {
        { OrderShareA S{nMe, 4, NE * 8, nb, bid, 8}; EpiDownGate E{YFp, GATE, nMe};
          pg8::gemm_phase<EpiDownGate, OrderShareA, true, true, false, false, true>(lds, g, S, E); }
        { OrderCtxSplitK S{nb, bid}; EpiDownCtxPart E{Y2p, GATE};
          pg8::gemm_phase<EpiDownCtxPart, OrderCtxSplitK, true, true, false, true, true>(lds, g, S, E); }
    }
}
#define SSQ ((float*)(ws + WS_PSSQ))
#define MOD ((float*)(ws + WS_MOD))
#define LB1 ((float*)(ws + WS_LB1))
#define RDA ((float2*)(ws + WS_RDA))
#define RR ((float2*)(ws + WS_RR))
#define X ((bf16_t*)(ws + WS_X))
#define H ((bf16_t*)(ws + WS_H))
#define AFF ((float*)(ws + WS_AFF))
#define SEL ((int*)(ws + WS_SEL))
#define AROW ((int*)(ws + WS_AROW))
#define GATE ((float*)(ws + WS_GATE))
#define QK ((bf16_t*)(ws + WS_QK))
#define V1 ((bf16_t*)(ws + WS_V1))
#define CQ ((bf16_t*)(ws + WS_CQ))
#define CKV ((bf16_t*)(ws + WS_CKV))
#define KR ((bf16_t*)(ws + WS_KR))
#define QM ((bf16_t*)(ws + WS_QM))
#define KVM ((bf16_t*)(ws + WS_KVM))
#define ODA ((float*)(ws + WS_ODA))
#define AO ((bf16_t*)(ws + WS_AO))
#define HIDB ((unsigned char*)(ws + WS_HIDB))
#define H8 ((unsigned char*)(ws + WS_H8))
#define WGU8 ((unsigned char*)(ws + WS_WGU))
#define WDT8 ((unsigned char*)(ws + WS_WD))
#define YF ((bf16_t*)(ws + WS_YF))
#define Y2 ((bf16_t*)(ws + WS_Y2))
#define CPART ((bf16_t*)(ws + WS_HIDB))
#define RB ((bf16_t*)(ws + WS_RB))
#define LF ((bf16_t*)(ws + WS_LF))
#define LAD ((bf16_t*)(ws + WS_LF + 36 * MiB))
#define GD ((float*)(ws + WS_GD))
#define KVT0 ((unsigned*)(ws + WS_KVT0))
#define KVT1 ((unsigned*)(ws + WS_KVT1))
#define SST0 ((bf16_t*)(ws + WS_SST0))
#define SST1 ((bf16_t*)(ws + WS_SST1))
#define DEC ((float*)(ws + WS_DEC))
#define R ((bf16_t*)(ws + WS_R))
#define WIN ((bf16_t*)(ws + WS_WIN))
#define WQ ((bf16_t*)(ws + WS_WQ))
#define WKV ((bf16_t*)(ws + WS_WKV))
#define WO ((bf16_t*)(ws + WS_WO))
#define WRI ((bf16_t*)(ws + WS_WRI))
#define WRO ((bf16_t*)(ws + WS_WRO))
#define WGU ((bf16_t*)(ws + WS_WGU))
#define WDT ((bf16_t*)(ws + WS_WD))
#define MOD1 (MOD + 9 * 6144)
__global__ void __launch_bounds__(NT, 2) fwd(Args args) {
    extern __shared__ __attribute__((aligned(16))) unsigned char lds_raw[];
    float* lds = (float*)lds_raw;
    LAS unsigned char* ldsl = (LAS unsigned char*)lds_raw;
    const int tid = threadIdx.x, lane = tid & 63, wave = __builtin_amdgcn_readfirstlane(tid >> 6), bid = blockIdx.x, nb = gridDim.x;
    unsigned char* ws = args.ws;
    volatile LAS unsigned* MISC = (volatile LAS unsigned*)(ldsl + MISC_OFF);
    if (tid < 32) MISC[tid] = 0u;
    __syncthreads();
    XcdBarrier bar; bar.bar = (unsigned*)(ws + WS_CTL) + CW_BAR; bar.x = 0; bar.st = nullptr;
#if MK_ONE_LAUNCH
    bar = xcd_barrier_post((unsigned*)(ws + WS_CTL) + CW_BAR, MISC + 8);
#endif
    const int lo = args.ph_lo, hi = args.ph_hi;
#ifdef ONLY_PHASE
#define IN(k) ((k) == ONLY_PHASE && lo <= (k) && (k) < hi)
#else
#define IN(k) (lo <= (k) && (k) < hi)
#endif
#if MK_ONE_LAUNCH
#define SEAM(k) do { if (IN(k) && IN((k) + 1)) xcd_barrier(bar); } while (0)
#define SEAM12() do { if (IN(12) && IN(14)) xcd_barrier(bar); } while (0)
#define SEAM2(a, b) do { if (IN(a) && IN(b)) xcd_barrier(bar); } while (0)
#else
#define SEAM(k) do { } while (0)
#define SEAM12() do { } while (0)
#define SEAM2(a, b) do { } while (0)
#endif

    if (IN(0)) {
        const size_t gtid = (size_t)bid * NT + tid, gthreads = (size_t)nb * NT;
        for (size_t i = gtid; i < (size_t)TT * 32; i += gthreads) { const int tp = (int)(i >> 5), j = (int)(i & 31); float2 cs = make_float2(1.f, 0.f);
            if (tp >= CTX) { const int t = tp - CTX; const float ang = (float)(j < 16 ? (t >> 6) : (t & 63)) * powf(10000.f, -(float)(j & 15) * (1.f / 16.f)); cs = make_float2(cosf(ang), sinf(ang)); }
            RDA[i] = cs; }
        for (size_t i = gtid; i < (size_t)TT * 16; i += gthreads) { const int tp = (int)(i >> 4), j = (int)(i & 15); float2 cs = make_float2(1.f, 0.f);
            if (tp >= CTX) { const int t = tp - CTX; const float ang = (float)(j < 8 ? (t >> 6) : (t & 63)) * powf(10000.f, -(float)(j & 7) * (1.f / 8.f)); cs = make_float2(cosf(ang), sinf(ang)); }
            RR[i] = cs; }
        { const float* lbl = args.in[I_LBL];
          for (size_t i = gtid; i < 1024; i += gthreads) { const float l0 = lbl[i], l1 = lbl[1024 + i], mx = fmaxf(l0, l1), e0 = expf(l0 - mx), e1 = expf(l1 - mx); LB1[i] = e1 / (e0 + e1); } }
        const float* c = args.in[I_C]; const float* cc = args.in[I_CCTX]; const float* adaw = args.in[I_ADAW]; const float* adab = args.in[I_ADAB];
        float* sc = lds; float* red = lds + 9 * 1024;
        for (int u = bid; u < 192; u += nb) {
            const int layer = u / 96, cb = u - layer * 96;
            __syncthreads();
            for (int i = tid; i < 9 * 1024; i += NT) { const int r = i >> 10, k = i & 1023; sc[i] = siluf(r < 8 ? c[r * 1024 + k] : cc[k]); }
            __syncthreads();
            const int kg = tid >> 6, col = cb * 64 + lane;
            float acc[9];
#pragma unroll
            for (int r = 0; r < 9; ++r) acc[r] = 0.f;
            for (int k = kg * 128; k < kg * 128 + 128; ++k) { const float w = adaw[((size_t)layer * 1024 + k) * 6144 + col];
#pragma unroll
                for (int r = 0; r < 9; ++r) acc[r] = fmaf(sc[r * 1024 + k], w, acc[r]); }
#pragma unroll
            for (int r = 0; r < 9; ++r) red[(kg * 9 + r) * 64 + lane] = acc[r];
            __syncthreads();
            for (int i = tid; i < 9 * 64; i += NT) { const int r = i >> 6, l = i & 63; float s = 0.f;
#pragma unroll
                for (int q = 0; q < 8; ++q) s += red[(q * 9 + r) * 64 + l];
                MOD[(layer * 9 + r) * 6144 + cb * 64 + l] = s + adab[layer * 6144 + cb * 64 + l]; }
        }
        __syncthreads();
        {
            LAS unsigned char* scr = ldsl + wave * 10240;
            const int gw = bid * NWAVES + wave, ngw = nb * NWAVES;
            constexpr int N_IN = 16 * 35, N_Q = 6 * 12, N_KV = 4 * 16, N_O = 16 * 16, N_RI = 16 * 65, N_RO = 16 * 16, N_TOT = N_IN + N_Q + N_KV + N_O + N_RI + N_RO;
            int it0 = gw, istep = ngw, ilim = N_TOT;
            if (nb == 256) { if (bid >= 192) { it0 = (bid - 192) * NWAVES + wave; istep = 512; ilim = 1536; } else { it0 = 1536 + gw; istep = 1 << 20; } }
            for (int it = it0; it < ilim; it += istep) {
                int r = it;
                if (r < N_IN) { conv_item(args.in[I_ATTWIN], ATT_IN, ATT_IN, D, (r / 35) * 64, (r % 35) * 64, WIN, MapAttIn{}, nullptr, scr, lane); continue; }
                r -= N_IN;
                if (r < N_Q) { conv_item(args.in[I_QUP], 768, 768, 384, (r / 12) * 64, (r % 12) * 64, WQ, MapQUp{}, args.in[I_QNG], scr, lane); continue; }
                r -= N_Q;
                if (r < N_KV) { conv_item(args.in[I_KVUP], 1024, 1024, 256, (r / 16) * 64, (r % 16) * 64, WKV, MapKVUp{}, args.in[I_KVNG], scr, lane); continue; }
                r -= N_KV;
                if (r < N_O) { conv_item(args.in[I_ATTWOUT], D, D, D, (r / 16) * 64, (r % 16) * 64, WO, MapIdent{}, nullptr, scr, lane); continue; }
                r -= N_O;
                if (r < N_RI) { conv_item(args.in[I_RECWIN], REC_IN, REC_IN, D, (r / 65) * 64, (r % 65) * 64, WRI, MapRecIn{}, nullptr, scr, lane); continue; }
                r -= N_RI;
                conv_item(args.in[I_RECWOUT], D, D, D, (r / 16) * 64, (r % 16) * 64, WRO, MapIdent{}, nullptr, scr, lane);
            }
        }
    }
    SEAM(0);
    if (IN(1)) phase_norm1(args.in[I_X], args.in[I_CTX], H, args.in[I_N1G], MOD, bid, nb);
    SEAM(1);
    if (IN(2)) {
        pg8::Gemm g{H, WIN, MT, 2304, D}; pg8::StaticOrder S; S.init(MT, 2304, nb, bid);
        EpiAttnIn E{QK, V1, CQ, CKV, KR, SSQ, RDA, RR};
        pg8::gemm_phase<EpiAttnIn, pg8::StaticOrder, true, true>(ldsl, g, S, E);
        if (nb == 256 && bid >= 136) { const ConvCtx c0{args.in[I_WG], args.in[I_WU], args.in[I_WD], WGU8, WDT8, 0, 0, 0};
            conv_tail(c0, ldsl, N_ATTITEMS, 4, (bid - 136) * NWAVES + wave, 120 * NWAVES, N_ATTITEMS + N_TAIL2); }
    }
    SEAM(2);
    if (IN(3)) {
        { pg8::Gemm g{CQ, WQ, MT, 768, 384}; pg8::StaticOrder S; S.init(MT, 768, nb, bid); EpiMlaQ E{QM, SSQ, RR};
          pg8::gemm_phase<EpiMlaQ, pg8::StaticOrder, true, true>(ldsl, g, S, E); }
        { pg8::Gemm g{CKV, WKV, MT, 1024, 256}; pg8::StaticOrder S; S.init(MT, 1024, nb, (bid + 40) % nb); EpiMlaKV E{KVM, SSQ};
          pg8::gemm_phase<EpiMlaKV, pg8::StaticOrder, true, true>(ldsl, g, S, E); }
    }
    SEAM(3);
    if (IN(4)) {
        const float* lq1 = args.in[I_LQ1]; const float* lk1 = args.in[I_LK1]; const float* lq2 = args.in[I_LQ2]; const float* lk2 = args.in[I_LK2];
        float d1 = 0.f, d2 = 0.f;
        for (int i = 0; i < 64; ++i) { d1 = fmaf(lq1[i], lk1[i], d1); d2 = fmaf(lq2[i], lk2[i], d2); }
        const float lam_init = 0.2f, lam = expf(d1) - expf(d2) + lam_init;
        ConvCtx cc{args.in[I_WG], args.in[I_WU], args.in[I_WD], WGU8, WDT8, 0, nb * NWAVES, bid * NWAVES + __builtin_amdgcn_readfirstlane(threadIdx.x >> 6)};
        const int nslots = bid < 864 ? (864 - bid + nb - 1) / nb : 0; const bool mla_first = nb == 256 && ((bid >> 3) & 1);
        for (int js = 0; js < nslots; ++js) {
            const int u = bid + nb * ((mla_first && js < 3) ? (js + 1) % 3 : js);
            int kind, b, hm, qb;
            if (u < 256) { const int x = u & 7, j = u >> 3, pair = (j >> 3) * 8 + x; kind = 0; qb = 1 + (j & 7); b = pair >> 2; hm = pair & 3; }
            else if (u < 768) { const int uu = u - 256, x = uu & 7, j = uu >> 3, pair = (j >> 3) * 8 + x; kind = 1; qb = 1 + (j & 7); b = pair >> 3; hm = pair & 7; }
            else { const int uu = u - 768; qb = 0; if (uu < 32) { kind = 0; b = uu >> 2; hm = uu & 3; } else { kind = 1; b = (uu - 32) >> 3; hm = (uu - 32) & 7; } }
            const int qrow0 = b * TT + qb * 256, krow0 = b * TT, nk = qb == 0 ? CTX : TT;
            if (kind == 0) { const int h = hm;
                attn_unit_mfma<64, 128, 1>(ldsl, QK + h * 128, nullptr, 1024, QK + 512 + h * 128, 1024, nullptr, 0, V1 + h * 128, 512, qrow0, krow0, nk, nullptr, 0, 0.f, nullptr, 0.f);
                attn_unit_mfma<64, 128, 2>(ldsl, QK + h * 128 + 64, nullptr, 1024, QK + 512 + h * 128 + 64, 1024, nullptr, 0, V1 + h * 128, 512, qrow0, krow0, nk, AO + h * 128, 1024, lam, args.in[I_SUBLN], 1.f - lam_init); }
            else { const int h = hm;
                attn_unit_mfma<96, 64, 0, true>(ldsl, QM + h * 64, QM + 512 + h * 32, 768, KVM + h * 64, 1024, KR, 32, KVM + 512 + h * 64, 1024, qrow0, krow0, nk, AO + 512 + h * 64, 1024, 0.f, nullptr, 0.f, &cc); }
        }
        {
            LAS unsigned char* scr = ldsl + 61440 + cc.offset % NWAVES * 10240; const int lane = threadIdx.x & 63;
            for (;; ++cc.n) { const int item = conv_item_index(cc, cc.n); if (item >= conv_att_limit(cc)) break;
                const ConvItem it = conv_decode_l1(cc, item); float4 cv[8];
#pragma unroll 1
                for (int q = 0; q < 2; ++q) { conv_q_issue(it, q, cv, lane); conv_q_stash(q, cv, scr, lane); }
                conv_finish(it, scr, lane); }
        }
    }
    SEAM2(4, 6);
    if (IN(6)) {
        { pg8::Gemm g{AO, WO, MT, D, D}; LatentOrder S; S.init(64 * 256, D, nb, bid); EpiResid2<true> E{X, MOD, args.in[I_X], args.in[I_CTX]};
          pg8::gemm_phase<EpiResid2<true>, LatentOrder, true, true>(ldsl, g, S, E); }
        { pg8::Gemm g{AO, WO, MT, D, D}; OrderCtxSplitK4 S{nb, bid}; EpiCtxPart E{CPART};
          pg8::gemm_phase<EpiCtxPart, OrderCtxSplitK4, true, true, false, true>(ldsl, g, S, E); }
    }
    SEAM(6);
    if (IN(7)) phase_norm2_router(ldsl, X, H8, args.in[I_N2G], MOD, args.in[I_ROUTER], AFF, SEL, bid, nb, false, CPART, args.in[I_CTX]);
    SEAM(7);
    if (IN(8)) phase_topk(ldsl, AFF, SEL, AROW, GATE, true, bid, nb);
    SEAM2(8, 10);
    if (IN(10)) { phase_moe_up(ldsl, H8, AROW, WGU8, HIDB, MEXP, bid, nb);
        if (nb == 256 && bid >= 96) { const ConvCtx c0{args.in[I_WG], args.in[I_WU], args.in[I_WD], WGU8, WDT8, 0, 0, 0};
            conv_tail(c0, ldsl, N_ATTITEMS + N_TAIL2, 2, (bid - 96) * NWAVES + wave, 160 * NWAVES, N_ATTITEMS + N_TAIL2 + N_TAIL10); } }
    SEAM(10);
    if (IN(11)) { phase_moe_down(ldsl, HIDB, WDT8, YF, Y2, GATE, MEXP, bid, nb); }
    SEAM(11);
    if (IN(12)) phase_combine(X, YF, Y2, SEL, MEXP, MOD, false, nullptr, nullptr, H, args.in[I_N1G] + D, MOD1, bid, nb);
    SEAM12();
    if (IN(14)) {
        pg8::Gemm g{H, WRI, MT, 4352, D}; pg8::StaticOrder S; S.init(MT, 4352, nb, bid); EpiRecIn E{RB, LF, GD, LB1};
        pg8::gemm_phase<EpiRecIn, pg8::StaticOrder, true, true>(ldsl, g, S, E);
        if (nb == 256 && bid >= 200) { const ConvCtx c0{args.in[I_WG], args.in[I_WU], args.in[I_WD], WGU8, WDT8, 0, 0, 0};
            conv_tail(c0, ldsl, N_ATTITEMS + N_TAIL2 + N_TAIL10, 4, (bid - 200) * NWAVES + wave, 56 * NWAVES, N_L1ITEMS); }
    }
    SEAM(14);
    if (IN(15)) {
        for (int u = bid; u < 2304; u += nb) { const int kind = u < 1152 ? 1 : 0, uu = u % 1152, c = uu % 36, ck = uu / 36, b = ck >> 2, h = ck & 3;
            if (kind) scan_s1_unit<1>(ldsl, b, h, c, RB, LF, GD, args.in[I_GKUP], args.in[I_GKB], KVT1, DEC, LAD);
            else scan_s1_unit<0>(ldsl, b, h, c, RB, LF, GD, args.in[I_GKUP], args.in[I_GKB], KVT0, DEC, LAD); }
    }
    SEAM(15);
    if (IN(16)) scan_s2(KVT0, KVT1, DEC, SST0, SST1, bid, nb);
    SEAM(16);
    if (IN(17)) {
        for (int u = bid; u < 2048; u += nb) { const int kind = u < 1024 ? 1 : 0, uu = u & 1023, lc = uu & 31, ck = uu >> 5, b = ck >> 2, h = ck & 3;
            if (kind) scan_s3_unit<1>(ldsl, b, h, lc, RB, LF, GD, args.in[I_GKUP], args.in[I_GKB], SST1, args.in[I_HGNG], R, LAD);
            else scan_s3_unit<0>(ldsl, b, h, lc, RB, LF, GD, args.in[I_GKUP], args.in[I_GKB], SST0, args.in[I_GLANG], R, LAD); }
    }
    SEAM(17);
    if (IN(18)) {
        pg8::Gemm g{R, WRO, MT, D, D}; LatentOrder S; S.init(64 * 256, D, nb, bid); EpiResid2<false> E{X, MOD1, nullptr, nullptr};
        pg8::gemm_phase<EpiResid2<false>, LatentOrder, true, true>(ldsl, g, S, E);
    }
    SEAM(18);
    if (IN(19)) phase_norm2_router(ldsl, X, H8, args.in[I_N2G] + D, MOD1, args.in[I_ROUTER] + D * NE, AFF, SEL, bid, nb, true, nullptr, nullptr);
    SEAM(19);
    if (IN(20)) phase_topk(ldsl, AFF, SEL, AROW, GATE, false, bid, nb);
    SEAM2(20, 22);
    if (IN(22)) phase_moe_up(ldsl, H8, AROW, WGU8 + (size_t)NE * 5632 * D, HIDB, 2048, bid, nb);
    SEAM(22);
    if (IN(23)) phase_moe_down(ldsl, HIDB, WDT8 + (size_t)NE * D * FF, YF, nullptr, GATE, 2048, bid, nb);
    SEAM(23);
    if (IN(24)) phase_combine(X, YF, nullptr, SEL, 2048, MOD1, true, args.in[I_FNG], args.out, nullptr, nullptr, nullptr, bid, nb);
#undef IN
#undef SEAM
}

extern "C" void kernel_launch(void* const* d_in, const int* in_sizes, int n_in, void* d_out, int out_size, void* d_ws, size_t ws_size, hipStream_t stream) {
    static int grid = 0;
    if (grid == 0) {
        if (n_in != 31 || out_size != NB * SEQ * D || ws_size < WS_END) { fprintf(stderr, "kernel_launch: unexpected problem (n_in %d out %d ws %zu need %zu)\n", n_in, out_size, ws_size, (size_t)WS_END); grid = -1; return; }
        int dev = 0, cus = 0, per_cu = 0;
        if (hipGetDevice(&dev) != hipSuccess || hipDeviceGetAttribute(&cus, hipDeviceAttributeMultiprocessorCount, dev) != hipSuccess) { grid = -1; return; }
        if (hipFuncSetAttribute((const void*)fwd, hipFuncAttributeMaxDynamicSharedMemorySize, LDS_BYTES) != hipSuccess) { fprintf(stderr, "kernel_launch: hipFuncSetAttribute failed\n"); grid = -1; return; }
        if (hipOccupancyMaxActiveBlocksPerMultiprocessor(&per_cu, (const void*)fwd, NT, LDS_BYTES) != hipSuccess || per_cu < 1) { fprintf(stderr, "kernel_launch: occupancy query says %d\n", per_cu); }
        (void)hipGetLastError();
        grid = cus;
    }
    if (grid < 0) return;
    (void)hipMemsetAsync((char*)d_ws + WS_CTL, 0, CTL_ZERO_BYTES, stream);
    Args a{};
    for (int i = 0; i < 31; ++i) a.in[i] = (const float*)d_in[i];
    a.out = (float*)d_out; a.ws = (unsigned char*)d_ws;
#if MK_ONE_LAUNCH
    a.ph_lo = 0; a.ph_hi = N_PHASES;
    hipLaunchKernelGGL(fwd, dim3(grid), dim3(NT), LDS_BYTES, stream, a);
#else
    for (int p = 0; p < N_PHASES - 1; ++p) {
        int reps = 1;
        if (PROBE_REP == 1 && p == 0) reps = 2;
        if (PROBE_REP == 2 && p == 4) reps = 2;
        if (PROBE_REP == 3 && (p == 10 || p == 11 || p == 22 || p == 23)) reps = 2;
        if (PROBE_REP == 4 && (p == 15 || p == 16 || p == 17)) reps = 2;
        if (PROBE_REP == 5 && (p == 3 || p == 14)) reps = 2;
        if (PROBE_REP == 6 && (p == 1 || p == 5 || p == 7 || p == 8 || p == 9 || p == 13 || p == 19 || p == 20 || p == 21)) reps = 2;
        if (PROBE_REP == 7 && p == 15) reps = 2;
        if (PROBE_REP == 8 && p == 16) reps = 2;
        if (PROBE_REP == 9 && p == 17) reps = 2;
        if (PROBE_REP == 10 && p == 3) reps = 2;
        if (PROBE_REP == 11 && (p == 10 || p == 22)) reps = 2;
        if (PROBE_REP == 12 && (p == 11 || p == 23)) reps = 2;
        if (PROBE_REP == 13 && p == 2) reps = 2;
        if (PROBE_REP == 14 && p == 14) reps = 2;
        if (PROBE_REP == 15 && p == 1) reps = 2;
        if (PROBE_REP == 16 && (p == 7 || p == 19)) reps = 2;
        if (PROBE_REP == 17 && (p == 8 || p == 20)) reps = 2;
        if (PROBE_REP == 18 && p == 5) reps = 2;
        for (int r = 0; r < reps; ++r) { a.ph_lo = p; a.ph_hi = p + 1; hipLaunchKernelGGL(fwd, dim3(grid), dim3(NT), LDS_BYTES, stream, a); }
    }
#endif
}
```
